# Optimizing an MI355X kernel written in HIP

```python
import math
import jax, jax.numpy as jnp
from jax import lax
import numpy as np

D_MODEL = 1024
BATCH = 4
SEQ = 8192
DEPTH = 2

HEAD_DIM = 64
N_HEADS = D_MODEL // HEAD_DIM
N_KV_GROUPS = 2
HEADS_PER_GROUP = N_HEADS // N_KV_GROUPS
KV_DIM = N_KV_GROUPS * HEAD_DIM
CMP_BLOCK = 32
CMP_STRIDE = 16
CMP_HIDDEN = 256
SEL_BLOCK = 64
N_SELECT = 16
WINDOW = 512
Q_BLOCK = 128
SEL_FORCE = 100.0
ROPE_THETA = 10000.0
SCALE = HEAD_DIM ** -0.5
LRU_WIDTH = D_MODEL
LRU_HEADS = 16
LRU_BLOCK = LRU_WIDTH // LRU_HEADS
LRU_C = 8.0
CONV_WIDTH = 4
SSM_INNER = D_MODEL
SSM_HEAD_DIM = 64
SSM_HEADS = SSM_INNER // SSM_HEAD_DIM
SSM_GROUPS = 2
SSM_STATE = 128
SSM_CHUNK = 128
SSM_CONV_DIM = SSM_INNER + 2 * SSM_GROUPS * SSM_STATE
PEER_HEADS = 8
PEER_KEYS = 128
PEER_EXPERTS = PEER_KEYS * PEER_KEYS
PEER_QUERY_DIM = 256
PEER_HALF = PEER_QUERY_DIM // 2
PEER_TOPK = 16
PEER_CHUNK = 128
N_BRANCH = 3
IN_SIZES = (N_HEADS * HEAD_DIM, 6 * KV_DIM, 3 * N_HEADS,
            LRU_WIDTH, LRU_WIDTH,
            SSM_INNER, SSM_CONV_DIM, SSM_HEADS,
            N_BRANCH * D_MODEL)
IN_COLS = sum(IN_SIZES)
EPS = 1e-6
NEG = -1e30

kernel_name = 'hybrid_nsa_rglru_ssd_peer'


def rms_norm(x, g):
    x32 = x.astype(jnp.float32)
    y = x32 * lax.rsqrt(jnp.mean(x32 * x32, axis=-1, keepdims=True) + EPS)
    return (y * g.astype(jnp.float32)).astype(x.dtype)


def rope(x, positions):
    half = x.shape[-1] // 2
    inv = ROPE_THETA ** (-jnp.arange(half, dtype=jnp.float32) / half)
    ang = positions.astype(jnp.float32)[..., None] * inv
    cos = jnp.cos(ang)[:, :, None, :]
    sin = jnp.sin(ang)[:, :, None, :]
    x32 = x.astype(jnp.float32)
    x1, x2 = x32[..., :half], x32[..., half:]
    return jnp.concatenate([x1 * cos - x2 * sin, x2 * cos + x1 * sin], axis=-1).astype(x.dtype)


def masked_softmax(s, mask):
    s32 = jnp.where(mask, s.astype(jnp.float32), NEG)
    return jax.nn.softmax(s32, axis=-1) * mask


def causal_conv(x, w, b):
    k_w, s = w.shape[0], x.shape[1]
    xp = jnp.pad(x, ((0, 0), (k_w - 1, 0), (0, 0)))
    out = b
    for k in range(k_w):
        out = out + xp[:, k:k + s] * w[k]
    return out


def segsum(a):
    t = a.shape[-1]
    rep = jnp.broadcast_to(a[..., None], a.shape + (t,))
    strict = jnp.tril(jnp.ones((t, t), dtype=bool), -1)
    cs = jnp.cumsum(jnp.where(strict, rep, 0.0), axis=-2)
    return jnp.where(jnp.tril(jnp.ones((t, t), dtype=bool)), cs, -jnp.inf)


def linear_recurrence_combine(left, right):
    a1, b1 = left
    a2, b2 = right
    return a1 * a2, a2 * b1 + b2


def nsa_branch(q, kv, gate_logits, positions, q_norm_g, k_norm_g, cmp_pe_k, cmp_pe_v,
               cmp_k_w1, cmp_k_w2, cmp_v_w1, cmp_v_w2):
    B, S = q.shape[:2]
    G, HG, dh = N_KV_GROUPS, HEADS_PER_GROUP, HEAD_DIM
    q = rope(rms_norm(q.reshape(B, S, N_HEADS, dh), q_norm_g), positions)
    k_c, v_c, k_s, v_s, k_w, v_w = [a.reshape(B, S, G, dh) for a in jnp.split(kv, 6, axis=-1)]
    k_c = rope(rms_norm(k_c, k_norm_g), positions)
    k_s = rope(rms_norm(k_s, k_norm_g), positions)
    k_w = rope(rms_norm(k_w, k_norm_g), positions)
    gates = jax.nn.sigmoid(gate_logits).reshape(B, S, G, HG, 3)

    n_cmp = (S - CMP_BLOCK) // CMP_STRIDE + 1
    cmp_start = CMP_STRIDE * jnp.arange(n_cmp)
    cmp_idx = cmp_start[:, None] + jnp.arange(CMP_BLOCK)[None, :]

    def compress(t, pe, w1, w2):
        blk = t[:, cmp_idx] + pe[None, None, :, None, :]
        blk = blk.transpose(0, 1, 3, 2, 4).reshape(B, n_cmp, G, CMP_BLOCK * dh)
        return jax.nn.gelu(blk @ w1) @ w2

    k_cmp = rms_norm(compress(k_c, cmp_pe_k, cmp_k_w1, cmp_k_w2), k_norm_g)
    v_cmp = compress(v_c, cmp_pe_v, cmp_v_w1, cmp_v_w2)
    cmp_end = cmp_start + CMP_BLOCK - 1

    n_sel = S // SEL_BLOCK
    n_pick = min(N_SELECT, n_sel)
    sel_start = SEL_BLOCK * jnp.arange(n_sel)
    overlap = jnp.clip(jnp.minimum(cmp_start[:, None] + CMP_BLOCK, sel_start[None, :] + SEL_BLOCK)
                       - jnp.maximum(cmp_start[:, None], sel_start[None, :]), 0).astype(jnp.float32) / CMP_BLOCK
    ks_blk = k_s.reshape(B, n_sel, SEL_BLOCK, G, dh).transpose(0, 3, 1, 2, 4)
    vs_blk = v_s.reshape(B, n_sel, SEL_BLOCK, G, dh).transpose(0, 3, 1, 2, 4)
    b_ix = jnp.arange(B)[:, None, None, None]
    g_ix = jnp.arange(G)[None, :, None, None]
    blk_ids = jnp.arange(n_sel)

    kw_pad = jnp.pad(k_w, ((0, 0), (WINDOW, 0), (0, 0), (0, 0)))
    vw_pad = jnp.pad(v_w, ((0, 0), (WINDOW, 0), (0, 0), (0, 0)))

    n_qb = S // Q_BLOCK
    q_blocks = q.reshape(B, n_qb, Q_BLOCK, G, HG, dh).transpose(1, 0, 2, 3, 4, 5)
    g_blocks = gates.reshape(B, n_qb, Q_BLOCK, G, HG, 3).transpose(1, 0, 2, 3, 4, 5)

    def query_block(args):
        qb, gb, ib = args
        t = ib * Q_BLOCK + jnp.arange(Q_BLOCK)
        s_c = jnp.einsum('bqghd,bcgd->bghqc', qb, k_cmp) * SCALE
        p_c = masked_softmax(s_c, cmp_end[None, :] <= t[:, None])
        o_c = jnp.einsum('bghqc,bcgd->bqghd', p_c.astype(qb.dtype), v_cmp)
        imp = jnp.einsum('bghqc,cj->bgqj', p_c, overlap)
        cur = t // SEL_BLOCK
        causal_blk = sel_start[None, :] <= t[:, None]
        forced = (blk_ids[None, :] == 0) | (blk_ids[None, :] == cur[:, None]) | (blk_ids[None, :] == cur[:, None] - 1)
        score = jnp.where(forced, SEL_FORCE, jnp.where(causal_blk, imp, -1.0))
        _, sel = lax.top_k(score, n_pick)
        kg = ks_blk[b_ix, g_ix, sel]
        vg = vs_blk[b_ix, g_ix, sel]
        key_pos = sel[..., None] * SEL_BLOCK + jnp.arange(SEL_BLOCK)
        mask_s = (key_pos <= t[None, None, :, None, None]).reshape(B, G, 1, Q_BLOCK, n_pick * SEL_BLOCK)
        s_s = jnp.einsum('bqghd,bgqnld->bghqnl', qb, kg) * SCALE
        p_s = masked_softmax(s_s.reshape(B, G, HG, Q_BLOCK, n_pick * SEL_BLOCK), mask_s)
        p_s = p_s.reshape(B, G, HG, Q_BLOCK, n_pick, SEL_BLOCK).astype(qb.dtype)
        o_s = jnp.einsum('bghqnl,bgqnld->bqghd', p_s, vg)
        kw = lax.dynamic_slice_in_dim(kw_pad, ib * Q_BLOCK, Q_BLOCK + WINDOW, axis=1)
        vw = lax.dynamic_slice_in_dim(vw_pad, ib * Q_BLOCK, Q_BLOCK + WINDOW, axis=1)
        s_pos = ib * Q_BLOCK - WINDOW + jnp.arange(Q_BLOCK + WINDOW)
        mask_w = (s_pos[None, :] <= t[:, None]) & (s_pos[None, :] > t[:, None] - WINDOW) & (s_pos[None, :] >= 0)
        s_w = jnp.einsum('bqghd,bkgd->bghqk', qb, kw) * SCALE
        p_w = masked_softmax(s_w, mask_w)
        o_w = jnp.einsum('bghqk,bkgd->bqghd', p_w.astype(qb.dtype), vw)
        return gb[..., 0:1] * o_c + gb[..., 1:2] * o_s + gb[..., 2:3] * o_w

    out = lax.map(query_block, (q_blocks, g_blocks, jnp.arange(n_qb)))
    return out.transpose(1, 0, 2, 3, 4, 5).reshape(B, S, N_HEADS * dh)


def rglru_branch(x_in, gate_in, positions, conv_w, conv_b, w_r, b_r, w_i, b_i, lam):
    B, S, _ = x_in.shape
    xc = causal_conv(x_in, conv_w, conv_b)
    xh = xc.reshape(B, S, LRU_HEADS, LRU_BLOCK)
    r = jax.nn.sigmoid(jnp.einsum('bshi,hij->bshj', xh, w_r).reshape(B, S, LRU_WIDTH) + b_r)
    i = jax.nn.sigmoid(jnp.einsum('bshi,hij->bshj', xh, w_i).reshape(B, S, LRU_WIDTH) + b_i)
    log_a = -LRU_C * r.astype(jnp.float32) * jax.nn.softplus(-lam.astype(jnp.float32))
    reset = (positions == 0)[..., None]
    a = jnp.where(reset, 0.0, jnp.exp(log_a))
    mult = jnp.where(reset, 1.0, jnp.sqrt(-jnp.expm1(2.0 * log_a)))
    b = mult * (i * xc).astype(jnp.float32)
    _, h = lax.associative_scan(linear_recurrence_combine, (a, b), axis=1)
    return h.astype(x_in.dtype) * jax.nn.gelu(gate_in)


def ssd_chunked(x, dt, A, bm, cm):
    B, S = x.shape[:2]
    c, L = S // SSM_CHUNK, SSM_CHUNK
    G, HG, P, N = SSM_GROUPS, SSM_HEADS // SSM_GROUPS, SSM_HEAD_DIM, SSM_STATE
    X = (x.astype(jnp.float32) * dt[..., None]).reshape(B, c, L, G, HG, P)
    adt = (dt * A).reshape(B, c, L, G, HG).transpose(0, 3, 4, 1, 2)
    Bc = bm.astype(jnp.float32).reshape(B, c, L, G, N)
    Cc = cm.astype(jnp.float32).reshape(B, c, L, G, N)
    a_cs = jnp.cumsum(adt, axis=-1)
    decay = jnp.exp(segsum(adt))
    cb = jnp.einsum('bclgn,bcsgn->bgcls', Cc, Bc)
    y_diag = jnp.einsum('bghcls,bcsghp->bclghp', cb[:, :, None] * decay, X)
    decay_states = jnp.exp(a_cs[..., -1:] - a_cs).transpose(0, 3, 4, 1, 2)[..., None]
    states = jnp.einsum('bclgn,bclghp->bcghpn', Bc, X * decay_states)
    chunk_tot = jnp.pad(a_cs[..., -1], ((0, 0), (0, 0), (0, 0), (1, 0)))
    decay_chunk = jnp.exp(segsum(chunk_tot))
    states = jnp.concatenate([jnp.zeros_like(states[:, :1]), states], axis=1)
    states = jnp.einsum('bghzc,bcghpn->bzghpn', decay_chunk, states)[:, :-1]
    y_off = jnp.einsum('bclgn,bcghpn->bclghp', Cc, states) * jnp.exp(a_cs).transpose(0, 3, 4, 1, 2)[..., None]
    return (y_diag + y_off).reshape(B, S, SSM_HEADS, P).astype(x.dtype)


def ssd_branch(z, xbc, dt_raw, conv_w, conv_b, dt_bias, a_log, d_skip, norm_g):
    B, S, _ = z.shape
    xbc = jax.nn.silu(causal_conv(xbc, conv_w, conv_b))
    xs, bm, cm = jnp.split(xbc, [SSM_INNER, SSM_INNER + SSM_GROUPS * SSM_STATE], axis=-1)
    xs = xs.reshape(B, S, SSM_HEADS, SSM_HEAD_DIM)
    bm = bm.reshape(B, S, SSM_GROUPS, SSM_STATE)
    cm = cm.reshape(B, S, SSM_GROUPS, SSM_STATE)
    dt = jax.nn.softplus(dt_raw.astype(jnp.float32) + dt_bias.astype(jnp.float32))
    A = -jnp.exp(a_log.astype(jnp.float32))
    y = ssd_chunked(xs, dt, A, bm, cm) + d_skip[:, None] * xs
    y = y.reshape(B, S, SSM_INNER) * jax.nn.silu(z)
    y = rms_norm(y.reshape(B, S, SSM_GROUPS, SSM_INNER // SSM_GROUPS),
                 norm_g.reshape(SSM_GROUPS, SSM_INNER // SSM_GROUPS))
    return y.reshape(B, S, SSM_INNER)


def peer_ffn(h, w_q, sub_keys, u, v):
    B, S, D = h.shape
    n_ch = S // PEER_CHUNK
    hc = h.reshape(B, n_ch, PEER_CHUNK, D).transpose(1, 0, 2, 3)

    def chunk(hb):
        q = (hb @ w_q).reshape(B, PEER_CHUNK, PEER_HEADS, 2, PEER_HALF)
        s = jnp.einsum('bchxd,hxkd->bchxk', q, sub_keys).astype(jnp.float32)
        s1, i1 = lax.top_k(s[..., 0, :], PEER_TOPK)
        s2, i2 = lax.top_k(s[..., 1, :], PEER_TOPK)
        n_cand = PEER_TOPK * PEER_TOPK
        cand = (s1[..., :, None] + s2[..., None, :]).reshape(B, PEER_CHUNK, PEER_HEADS, n_cand)
        cidx = (i1[..., :, None] * PEER_KEYS + i2[..., None, :]).reshape(B, PEER_CHUNK, PEER_HEADS, n_cand)
        sc, pos = lax.top_k(cand, PEER_TOPK)
        eidx = jnp.take_along_axis(cidx, pos, axis=-1)
        g = jax.nn.softmax(sc, axis=-1)
        act = jax.nn.gelu(jnp.einsum('bchkd,bcd->bchk', u[eidx], hb).astype(jnp.float32))
        return jnp.einsum('bchk,bchkd->bcd', (g * act).astype(hb.dtype), v[eidx])

    out = lax.map(chunk, hc)
    return out.transpose(1, 0, 2, 3).reshape(B, S, D)


def hybrid_mixer(xn, positions, w_in, q_norm_g, k_norm_g, cmp_pe_k, cmp_pe_v, cmp_k_w1, cmp_k_w2,
                 cmp_v_w1, cmp_v_w2, lru_conv_w, lru_conv_b, lru_w_r, lru_b_r, lru_w_i, lru_b_i,
                 lru_lambda, ssm_conv_w, ssm_conv_b, ssm_dt_bias, ssm_a_log, ssm_d, ssm_norm_g,
                 w_branch, w_out):
    B, S, _ = xn.shape
    splits = np.cumsum(IN_SIZES)[:-1].tolist()
    a_q, a_kv, a_g, l_x, l_g, s_z, s_xbc, s_dt, m_g = [xn @ w for w in jnp.split(w_in, splits, axis=-1)]
    y_a = nsa_branch(a_q, a_kv, a_g, positions, q_norm_g, k_norm_g, cmp_pe_k, cmp_pe_v,
                     cmp_k_w1, cmp_k_w2, cmp_v_w1, cmp_v_w2)
    y_b = rglru_branch(l_x, l_g, positions, lru_conv_w, lru_conv_b, lru_w_r, lru_b_r,
                       lru_w_i, lru_b_i, lru_lambda)
    y_c = ssd_branch(s_z, s_xbc, s_dt, ssm_conv_w, ssm_conv_b, ssm_dt_bias, ssm_a_log, ssm_d, ssm_norm_g)
    merge_gates = jax.nn.sigmoid(m_g).reshape(B, S, N_BRANCH, D_MODEL)
    merged = (merge_gates[:, :, 0] * (y_a @ w_branch[0])
              + merge_gates[:, :, 1] * (y_b @ w_branch[1])
              + merge_gates[:, :, 2] * (y_c @ w_branch[2]))
    return merged @ w_out


def setup_inputs(seed: int = 0) -> dict:
    key = jax.random.key(seed)
    ks = jax.random.split(key, 32)
    f32 = jnp.float32
    L = DEPTH

    def nrm(k, shape, scale):
        return jax.random.normal(k, shape, f32) * scale

    def gain(k, shape):
        return 1.0 + 0.02 * jax.random.normal(k, shape, f32)

    u_lru = jax.random.uniform(ks[14], (L, LRU_WIDTH), f32, 0.9, 0.999)
    s_lru = u_lru ** (1.0 / LRU_C)
    dt0 = jnp.exp(jax.random.uniform(ks[17], (L, SSM_HEADS), f32, math.log(1e-3), math.log(1e-1)))
    return {
        'x': jax.random.normal(ks[0], (BATCH, SEQ, D_MODEL), f32),
        'positions': jnp.broadcast_to(jnp.arange(SEQ, dtype=jnp.int32)[None, :], (BATCH, SEQ)),
        'mix_norm_g': gain(ks[1], (L, D_MODEL)),
        'w_in': nrm(ks[2], (L, D_MODEL, IN_COLS), D_MODEL ** -0.5),
        'q_norm_g': gain(ks[3], (L, HEAD_DIM)),
        'k_norm_g': gain(ks[4], (L, HEAD_DIM)),
        'cmp_pe_k': nrm(ks[5], (L, CMP_BLOCK, HEAD_DIM), 0.1),
        'cmp_pe_v': nrm(ks[6], (L, CMP_BLOCK, HEAD_DIM), 0.1),
        'cmp_k_w1': nrm(ks[7], (L, CMP_BLOCK * HEAD_DIM, CMP_HIDDEN), (CMP_BLOCK * HEAD_DIM) ** -0.5),
        'cmp_k_w2': nrm(ks[8], (L, CMP_HIDDEN, HEAD_DIM), CMP_HIDDEN ** -0.5),
        'cmp_v_w1': nrm(ks[9], (L, CMP_BLOCK * HEAD_DIM, CMP_HIDDEN), (CMP_BLOCK * HEAD_DIM) ** -0.5),
        'cmp_v_w2': nrm(ks[10], (L, CMP_HIDDEN, HEAD_DIM), CMP_HIDDEN ** -0.5),
        'lru_conv_w': nrm(ks[11], (L, CONV_WIDTH, LRU_WIDTH), CONV_WIDTH ** -0.5),
        'lru_conv_b': nrm(ks[12], (L, LRU_WIDTH), 0.01),
        'lru_w_r': nrm(ks[13], (L, LRU_HEADS, LRU_BLOCK, LRU_BLOCK), LRU_BLOCK ** -0.5),
        'lru_b_r': nrm(ks[15], (L, LRU_WIDTH), 0.01),
        'lru_w_i': nrm(ks[16], (L, LRU_HEADS, LRU_BLOCK, LRU_BLOCK), LRU_BLOCK ** -0.5),
        'lru_b_i': nrm(ks[18], (L, LRU_WIDTH), 0.01),
        'lru_lambda': jnp.log(s_lru) - jnp.log1p(-s_lru),
        'ssm_conv_w': nrm(ks[19], (L, CONV_WIDTH, SSM_CONV_DIM), CONV_WIDTH ** -0.5),
        'ssm_conv_b': nrm(ks[20], (L, SSM_CONV_DIM), 0.01),
        'ssm_dt_bias': dt0 + jnp.log(-jnp.expm1(-dt0)),
        'ssm_a_log': jnp.log(jax.random.uniform(ks[21], (L, SSM_HEADS), f32, 1.0, 16.0)),
        'ssm_d': 1.0 + 0.1 * jax.random.normal(ks[22], (L, SSM_HEADS), f32),
        'ssm_norm_g': gain(ks[23], (L, SSM_INNER)),
        'w_branch': nrm(ks[24], (L, N_BRANCH, D_MODEL, D_MODEL), D_MODEL ** -0.5),
        'w_out': nrm(ks[25], (L, D_MODEL, D_MODEL), D_MODEL ** -0.5),
        'ffn_norm_g': gain(ks[26], (L, D_MODEL)),
        'peer_w_q': nrm(ks[27], (L, D_MODEL, PEER_HEADS * PEER_QUERY_DIM), D_MODEL ** -0.5),
        'peer_sub_keys': nrm(ks[28], (L, PEER_HEADS, 2, PEER_KEYS, PEER_HALF), PEER_HALF ** -0.5),
        'peer_u': nrm(ks[29], (L, PEER_EXPERTS, D_MODEL), D_MODEL ** -0.5),
        'peer_v': nrm(ks[30], (L, PEER_EXPERTS, D_MODEL), PEER_HEADS ** -0.5),
    }


def reference(x, positions, mix_norm_g, w_in, q_norm_g, k_norm_g, cmp_pe_k, cmp_pe_v, cmp_k_w1,
              cmp_k_w2, cmp_v_w1, cmp_v_w2, lru_conv_w, lru_conv_b, lru_w_r, lru_b_r, lru_w_i,
              lru_b_i, lru_lambda, ssm_conv_w, ssm_conv_b, ssm_dt_bias, ssm_a_log, ssm_d,
              ssm_norm_g, w_branch, w_out, ffn_norm_g, peer_w_q, peer_sub_keys, peer_u, peer_v):
    for l in range(DEPTH):
        xn = rms_norm(x, mix_norm_g[l])
        x = x + hybrid_mixer(xn, positions, w_in[l], q_norm_g[l], k_norm_g[l], cmp_pe_k[l], cmp_pe_v[l],
                             cmp_k_w1[l], cmp_k_w2[l], cmp_v_w1[l], cmp_v_w2[l], lru_conv_w[l],
                             lru_conv_b[l], lru_w_r[l], lru_b_r[l], lru_w_i[l], lru_b_i[l],
                             lru_lambda[l], ssm_conv_w[l], ssm_conv_b[l], ssm_dt_bias[l],
                             ssm_a_log[l], ssm_d[l], ssm_norm_g[l], w_branch[l], w_out[l])
        x = x + peer_ffn(rms_norm(x, ffn_norm_g[l]), peer_w_q[l], peer_sub_keys[l], peer_u[l], peer_v[l])
    return x
```

```cpp
#define ONE_LAUNCH 1
#define DBG_BRANCH 7
#define DBG_PEER 1
#define DBG_LAYERS 2
#define REP_MASK 0u
#define PADV 0
#include <hip/hip_runtime.h>
#include <cstdio>
#include <cstdint>

#ifndef ONE_LAUNCH
#define ONE_LAUNCH 0
#endif
#ifndef DBG_BRANCH
#define DBG_BRANCH 7
#endif
#ifndef DBG_PEER
#define DBG_PEER 1
#endif
#ifndef DBG_LAYERS
#define DBG_LAYERS 2
#endif
namespace pg8 {
#define PG8_LAS __attribute__((address_space(3)))
typedef unsigned short bf16_t;
typedef short bf16x8 __attribute__((ext_vector_type(8)));
typedef float f32x4 __attribute__((ext_vector_type(4)));
typedef unsigned u32x4 __attribute__((ext_vector_type(4)));
constexpr int BM = 256, BK = 64, HALF = 128, HTB = HALF * BK * 2  , STAGE_BYTES = 8 * HTB, NXCD = 8, WGM = 8;

__host__ __device__ __forceinline__ int lds_byte(int r, int c) { const int st = (r >> 4) * 2 + (c >> 5), rr = r & 15, cc = c & 31, ob = rr * 64 + cc * 2; return st * 1024 + (ob ^ (((ob >> 9) & 1) << 5)); }
__host__ __device__ __forceinline__ void stage_rc(int b, int& R, int& C) { const int st = b / 1024, sb = b % 1024, swz = sb ^ (((sb >> 9) & 1) << 5); R = (st >> 1) * 16 + swz / 64; C = (st & 1) * 32 + (swz % 64) / 2; }
__host__ __device__ __forceinline__ int perm32(int rho) { const int n = rho >> 4, i = rho & 15; return 8 * (i >> 2) + 4 * n + (i & 3); }

struct Unit { int pm, pn; };
struct Gemm { const bf16_t* A; const bf16_t* Bt; int M, N, K; };

struct StaticOrder {
    int nM, nN, nwg, G, c;
    __host__ __device__ void init(int M, int N, int G_, int c_) { nM = M / BM; nN = N / BM; nwg = nM * nN; G = G_; c = c_; }
    __host__ __device__ bool next(int i, Unit& u) const {
        const long L = (long)i * G + c; if (L >= nwg) return false;
        int wgid = (int)L; { const int q = nwg / NXCD, r = nwg % NXCD, xcd = wgid % NXCD, off = wgid / NXCD; wgid = (xcd < r ? xcd * (q + 1) : r * (q + 1) + (xcd - r) * q) + off; }
        const int nig = WGM * nN, gid = wgid / nig, fm = gid * WGM, gsz = (nM - fm) < WGM ? (nM - fm) : WGM;
        u.pm = fm + ((wgid % nig) % gsz); u.pn = (wgid % nig) / gsz; return true;
    }
    __device__ __forceinline__ void a_ready(const Unit&) const {}
    __device__ __forceinline__ void done(const Unit&) const {}
};

__device__ __forceinline__ unsigned cvt_pk_bf16(float lo, float hi) { unsigned r; asm volatile("v_cvt_pk_bf16_f32 %0, %1, %2" : "=v"(r) : "v"(lo), "v"(hi)); return r; }
typedef int i32x4 __attribute__((ext_vector_type(4)));
typedef int i32x8 __attribute__((ext_vector_type(8)));
__device__ __forceinline__ i32x8 cat8(bf16x8 a, bf16x8 b) { return __builtin_shufflevector(__builtin_bit_cast(i32x4, a), __builtin_bit_cast(i32x4, b), 0, 1, 2, 3, 4, 5, 6, 7); }
template <class Epi, class Sched, bool ALIGN_EPI = false, bool SP2 = false, bool FP8 = false>
__device__ __forceinline__ void gemm_phase(PG8_LAS unsigned char* lds, const Gemm g, const Sched& S, const Epi& E) {
    int tid_ = threadIdx.x; asm volatile("" : "+v"(tid_)); const int tid = tid_ & 511, wid = __builtin_amdgcn_readfirstlane(tid >> 6), lane = tid & 63, wr = wid >> 2, wc = wid & 3, fr = lane & 15, fq = lane >> 4;
    const int K = g.K; int nt_ = K / BK; if constexpr (FP8) asm volatile("" : "+s"(nt_));
    const int nt = nt_;
    unsigned voffA[2], voffB[2];
#pragma unroll
    for (int i = 0; i < 2; ++i) { int R, C; stage_rc(tid * 16 + i * 8192, R, C); const int Rb = Epi::PERM ? ((R & ~31) + perm32(R & 31)) : R;
        voffA[i] = (unsigned)(R * K + C) * 2u; voffB[i] = (unsigned)(Rb * K + C) * 2u; }
    const size_t kstep = (size_t)(BK * 2);
    const size_t hstep = (size_t)HALF * K * 2;
    const size_t tstep = 2 * hstep;
    const unsigned ldsw = (unsigned)wid * 1024u;
    const int aoff = lds_byte(wr * 64 + fr, fq * 8), boff = lds_byte(wc * 32 + fr, fq * 8);
#define PG8_SA(b, h) (((b) * 2 + (h)) * HTB)
#define PG8_SB(b, h) ((4 + (b) * 2 + (h)) * HTB)
#define PG8_STAGE(bufoff, gbase, voff) do { _Pragma("unroll") for (int _i = 0; _i < 2; ++_i) \
        __builtin_amdgcn_global_load_lds((const unsigned*)((const char*)(gbase) + (voff)[_i]), (PG8_LAS unsigned*)(lds + (bufoff) + ldsw + _i * 8192), 16, 0, 0); } while (0)
#define PG8_LDA(dst, b, h) do { _Pragma("unroll") for (int m = 0; m < 4; ++m) _Pragma("unroll") for (int k = 0; k < 2; ++k) dst[m][k] = *(const PG8_LAS bf16x8*)(lds + PG8_SA(b, h) + aoff + m * 2048 + k * 1024); } while (0)
#define PG8_LDB(dst, b, h) do { _Pragma("unroll") for (int n = 0; n < 2; ++n) _Pragma("unroll") for (int k = 0; k < 2; ++k) dst[n][k] = *(const PG8_LAS bf16x8*)(lds + PG8_SB(b, h) + boff + n * 2048 + k * 1024); } while (0)
#define PG8_MMA(ai, bj, At, Bt) do { __builtin_amdgcn_s_setprio(1); _Pragma("unroll") for (int m = 0; m < 4; ++m) _Pragma("unroll") for (int n = 0; n < 2; ++n) { \
        if constexpr (FP8) { const i32x8 a8_ = cat8(Bt[n][0], Bt[n][1]), b8_ = cat8(At[m][0], At[m][1]); \
            asm volatile("v_mfma_scale_f32_16x16x128_f8f6f4 %0, %1, %2, %0, %3, %4 op_sel_hi:[0,0,0]" : "+v"(acc[ai][bj][m][n]) : "v"(a8_), "v"(b8_), "v"(sclw), "v"(scla)); } \
        else { _Pragma("unroll") for (int k = 0; k < 2; ++k) acc[ai][bj][m][n] = __builtin_amdgcn_mfma_f32_16x16x32_bf16(Bt[n][k], At[m][k], acc[ai][bj][m][n], 0, 0, 0); } } \
        __builtin_amdgcn_s_setprio(0); } while (0)
    int sclw = 121, scla = 127; asm volatile("" : "+v"(sclw), "+v"(scla));
#define PG8_WAIT_V(n) asm volatile("s_waitcnt vmcnt(" #n ")" ::: "memory")
#define PG8_WAIT_L(n) asm volatile("s_waitcnt lgkmcnt(" #n ")" ::: "memory")
#define PG8_BAR __builtin_amdgcn_s_barrier()
#define PG8_SCHED __builtin_amdgcn_sched_barrier(0)
    Unit cur, nxt; int ui = 0;
    if (!S.next(0, cur)) return;
    f32x4 acc[2][2][4][2];
#pragma unroll
    for (int a = 0; a < 2; ++a)
#pragma unroll
        for (int b = 0; b < 2; ++b)
#pragma unroll
            for (int m = 0; m < 4; ++m)
#pragma unroll
                for (int n = 0; n < 2; ++n) acc[a][b][m][n] = (f32x4){0.f, 0.f, 0.f, 0.f};
    bf16x8 At[4][2], B0[2][2], B1[2][2];
    const char* cA = (const char*)g.A + (size_t)cur.pm * tstep; const char* cB = (const char*)g.Bt + (size_t)cur.pn * tstep;
    S.a_ready(cur);
    if constexpr (SP2) {
        PG8_STAGE(PG8_SB(0, 0), cB, voffB); PG8_STAGE(PG8_SB(0, 1), cB + hstep, voffB); PG8_STAGE(PG8_SA(0, 0), cA, voffA); PG8_STAGE(PG8_SA(0, 1), cA + hstep, voffA);
        if (wr == 1) PG8_BAR;
        PG8_WAIT_V(2); PG8_BAR;
        PG8_STAGE(PG8_SB(1, 0), cB + kstep, voffB); PG8_STAGE(PG8_SA(1, 0), cA + kstep, voffA); PG8_STAGE(PG8_SB(1, 1), cB + hstep + kstep, voffB);
        PG8_WAIT_V(6); PG8_BAR;
    } else {
        PG8_STAGE(PG8_SB(0, 0), cB, voffB); PG8_STAGE(PG8_SA(0, 0), cA, voffA); PG8_STAGE(PG8_SB(0, 1), cB + hstep, voffB); PG8_STAGE(PG8_SA(0, 1), cA + hstep, voffA);
        if (wr == 1) PG8_BAR;
        PG8_WAIT_V(4); PG8_BAR;
        PG8_STAGE(PG8_SB(1, 0), cB + kstep, voffB); PG8_STAGE(PG8_SA(1, 0), cA + kstep, voffA); PG8_STAGE(PG8_SB(1, 1), cB + hstep + kstep, voffB);
        PG8_WAIT_V(6); PG8_BAR;
    }
    for (;;) {
        const bool has_next = S.next(ui + 1, nxt);
        const char* nA = has_next ? (const char*)g.A + (size_t)nxt.pm * tstep : cA; const char* nB = has_next ? (const char*)g.Bt + (size_t)nxt.pn * tstep : cB;
        for (int t = 0; t < nt; t += 2) {
            const bool last = (t == nt - 2);
            const char* a1 = cA + (size_t)(t + 1) * kstep;
            const char* a2 = last ? nA : cA + (size_t)(t + 2) * kstep; const char* b2 = last ? nB : cB + (size_t)(t + 2) * kstep;
            const char* a3 = a2 + kstep; const char* b3 = b2 + kstep;
            if (last && has_next) S.a_ready(nxt);
            if constexpr (SP2) {
            PG8_LDB(B0, 0, 0); PG8_LDB(B1, 0, 1); PG8_SCHED; PG8_LDA(At, 0, 0); PG8_STAGE(PG8_SA(1, 1), a1 + hstep, voffA);
            PG8_WAIT_V(8); PG8_WAIT_L(0); PG8_BAR; PG8_MMA(0, 0, At, B0); PG8_MMA(0, 1, At, B1); PG8_BAR; PG8_SCHED;
            PG8_LDA(At, 0, 1); PG8_STAGE(PG8_SB(0, 0), b2, voffB); PG8_STAGE(PG8_SB(0, 1), b2 + hstep, voffB); PG8_STAGE(PG8_SA(0, 0), a2, voffA);
            PG8_WAIT_V(8); PG8_WAIT_L(0); PG8_BAR; PG8_MMA(1, 0, At, B0); PG8_MMA(1, 1, At, B1); PG8_BAR; PG8_SCHED;
            PG8_LDB(B0, 1, 0); PG8_LDB(B1, 1, 1); PG8_SCHED; PG8_LDA(At, 1, 0); PG8_STAGE(PG8_SA(0, 1), a2 + hstep, voffA);
            PG8_WAIT_V(8); PG8_WAIT_L(0); PG8_BAR; PG8_MMA(0, 0, At, B0); PG8_MMA(0, 1, At, B1); PG8_BAR; PG8_SCHED;
            PG8_LDA(At, 1, 1); PG8_STAGE(PG8_SB(1, 0), b3, voffB); PG8_STAGE(PG8_SB(1, 1), b3 + hstep, voffB); PG8_STAGE(PG8_SA(1, 0), a3, voffA);
            PG8_WAIT_V(8); PG8_WAIT_L(0); PG8_BAR; PG8_MMA(1, 0, At, B0); PG8_MMA(1, 1, At, B1); PG8_BAR; PG8_SCHED;
            } else {
            PG8_LDB(B0, 0, 0); PG8_SCHED; PG8_LDA(At, 0, 0); PG8_STAGE(PG8_SA(1, 1), a1 + hstep, voffA);
            PG8_WAIT_L(8); PG8_BAR; PG8_WAIT_L(0); PG8_MMA(0, 0, At, B0); PG8_BAR; PG8_SCHED;
            PG8_LDB(B1, 0, 1); PG8_STAGE(PG8_SB(0, 0), b2, voffB);
            PG8_BAR; PG8_WAIT_L(0); PG8_MMA(0, 1, At, B1); PG8_BAR;
            PG8_LDA(At, 0, 1); PG8_STAGE(PG8_SA(0, 0), a2, voffA);
            PG8_BAR; PG8_WAIT_L(0); PG8_MMA(1, 0, At, B0); PG8_BAR; PG8_SCHED;
            PG8_STAGE(PG8_SB(0, 1), b2 + hstep, voffB);
            PG8_WAIT_V(6); PG8_BAR; PG8_MMA(1, 1, At, B1); PG8_BAR;
            PG8_LDB(B0, 1, 0); PG8_SCHED; PG8_LDA(At, 1, 0); PG8_STAGE(PG8_SA(0, 1), a2 + hstep, voffA);
            PG8_WAIT_L(8); PG8_BAR; PG8_WAIT_L(0); PG8_MMA(0, 0, At, B0); PG8_BAR; PG8_SCHED;
            PG8_LDB(B1, 1, 1); PG8_STAGE(PG8_SB(1, 0), b3, voffB);
            PG8_BAR; PG8_WAIT_L(0); PG8_MMA(0, 1, At, B1); PG8_BAR;
            PG8_LDA(At, 1, 1); PG8_STAGE(PG8_SA(1, 0), a3, voffA);
            PG8_BAR; PG8_WAIT_L(0); PG8_MMA(1, 0, At, B0); PG8_BAR; PG8_SCHED;
            PG8_STAGE(PG8_SB(1, 1), b3 + hstep, voffB);
            PG8_WAIT_V(6); PG8_BAR; PG8_MMA(1, 1, At, B1); PG8_BAR;
            }
        }
        if constexpr (FP8) asm volatile("s_nop 15\n\ts_nop 7" ::: "memory");
        if constexpr (ALIGN_EPI) { if (wr == 0) PG8_BAR; }
        if constexpr (!Epi::AFTER_DRAIN) { E(acc, cur, wr, wc, fr, fq); S.done(cur); }
        if (!has_next) break;
#pragma unroll
        for (int a = 0; a < 2; ++a)
#pragma unroll
            for (int b = 0; b < 2; ++b)
#pragma unroll
                for (int m = 0; m < 4; ++m)
#pragma unroll
                    for (int n = 0; n < 2; ++n) acc[a][b][m][n] = (f32x4){0.f, 0.f, 0.f, 0.f};
        cur = nxt; cA = nA; cB = nB; ++ui;
        if constexpr (ALIGN_EPI) { if (wr == 1) PG8_BAR; }
    }
    PG8_WAIT_V(0);
    if constexpr (!ALIGN_EPI) { if (wr == 0) PG8_BAR; }
    PG8_BAR;
    if constexpr (Epi::AFTER_DRAIN) { E.fused(acc, cur, wr, wc, fr, fq, lds, wid, lane); S.done(cur); }
#undef PG8_SA
#undef PG8_SB
#undef PG8_STAGE
#undef PG8_LDA
#undef PG8_LDB
#undef PG8_MMA
#undef PG8_WAIT_V
#undef PG8_WAIT_L
#undef PG8_BAR
#undef PG8_SCHED
}
}

#define LAS __attribute__((address_space(3)))
typedef unsigned short bf16;
typedef short bf16x8 __attribute__((ext_vector_type(8)));
typedef float f32x4 __attribute__((ext_vector_type(4)));
typedef float f32x16 __attribute__((ext_vector_type(16)));
typedef unsigned u32x4 __attribute__((ext_vector_type(4)));
typedef unsigned u32x2 __attribute__((ext_vector_type(2)));
typedef unsigned long long u64;

constexpr int NB = 4, SEQ = 8192, DM = 1024, MT = NB * SEQ, DEPTH = 2, INCOLS = 9536;
constexpr float EPS = 1e-6f;
constexpr int NPH = 18;
constexpr int NTHREADS = 512, NWAVES = 8;

constexpr size_t MiB = 1u << 20;
constexpr size_t WS_CTL = 0, CTL_ZERO_BYTES = 64 * 1024;
constexpr size_t WS_SK = 1 * MiB;
constexpr size_t WS_W1K = 2 * MiB, WS_W1V = 3 * MiB;
constexpr size_t WS_W2K = 4 * MiB, WS_W2V = 4 * MiB + 64 * 1024;
constexpr size_t WS_WRT = 4 * MiB + 128 * 1024, WS_WIT = 4 * MiB + 256 * 1024;
constexpr size_t WS_DEC = 4 * MiB + 512 * 1024;
constexpr size_t WS_WIN = 8 * MiB;
constexpr size_t WS_WMRG = 21 * MiB;
constexpr size_t WS_WOUT = 33 * MiB;
constexpr size_t WS_WQ = 35 * MiB;
constexpr size_t WS_XN = 40 * MiB, WS_YA = 104 * MiB, WS_YB = 168 * MiB, WS_YC = 232 * MiB;
constexpr size_t WS_R = 296 * MiB;
constexpr size_t WS_END = 512 * MiB;
constexpr size_t WS_XBC = WS_R, WS_STATES = WS_R, WS_MISC = WS_R + 200 * MiB;
constexpr size_t WS_XT = WS_YA, WS_BM = WS_YB, WS_CM = WS_YB + 16 * MiB, WS_BT = WS_YB + 32 * MiB, WS_DTV = WS_YB + 48 * MiB;
constexpr size_t WS_LX = WS_R + 96 * MiB, WS_LG = WS_YB, WS_AGG = WS_R + 160 * MiB, WS_CARRY = WS_R + 164 * MiB;
constexpr size_t WS_Q = WS_YA, WS_KV = WS_R, WS_KC = WS_R + 48 * MiB, WS_KS = WS_R + 56 * MiB, WS_KW = WS_YC,
                 WS_VST = WS_YC + 8 * MiB, WS_VWT = WS_YC + 16 * MiB, WS_KCMP = WS_YC + 24 * MiB, WS_VCMPT = WS_YC + 25 * MiB;
constexpr size_t WS_MERGED = WS_R, WS_GBUF = WS_R + 128 * MiB, WS_MBUF = WS_R + 96 * MiB;
constexpr size_t WS_XN8 = WS_R + 168 * MiB, WS_YC8 = WS_R + 64 * MiB, WS_YA8 = WS_XN, WS_YB8 = WS_XN + 32 * MiB;
constexpr int A8_TILE(size_t off) { return (int)((off - WS_YA8) / (256 * 1024)); }
constexpr size_t WS_HN = WS_XN, WS_PQ = WS_YA, WS_RIDX = WS_YC, WS_RG = WS_YC + 16 * MiB, WS_UB = WS_R, WS_VB = WS_R + 32 * MiB,
                 WS_U8 = WS_R, WS_V8 = WS_R + 16 * MiB, WS_SU = WS_R + 32 * MiB, WS_SV = WS_R + 33 * MiB, WS_PW = WS_R + 34 * MiB, WS_PWP = WS_R + 64 * MiB;

constexpr int WA_ROW0 = 0, WA_N = 2816;
constexpr int WB_ROW0 = 2816, WB_N = 2048;
constexpr int WC_ROW0 = 4864, WC_N = 1792;

constexpr int LDS_BYTES = 160 * 1024;
constexpr int MISC_OFF = LDS_BYTES - 256;

struct Params { const float* in[32]; float* out; unsigned char* ws; int ph_lo, ph_hi; unsigned rep_mask; int pad; };

__device__ __forceinline__ unsigned pk4_fp8(float a, float b, float c, float d) {
    int w = 0; w = __builtin_amdgcn_cvt_pk_fp8_f32(__builtin_amdgcn_fmed3f(a, -448.f, 448.f), __builtin_amdgcn_fmed3f(b, -448.f, 448.f), w, false);
    w = __builtin_amdgcn_cvt_pk_fp8_f32(__builtin_amdgcn_fmed3f(c, -448.f, 448.f), __builtin_amdgcn_fmed3f(d, -448.f, 448.f), w, true); return (unsigned)w; }

__device__ __forceinline__ float wave_sum(float v) {
#pragma unroll
    for (int o = 1; o < 64; o <<= 1) v += __shfl_xor(v, o);
    return v;
}
__device__ __forceinline__ float half_sum(float v) {
#pragma unroll
    for (int o = 1; o < 32; o <<= 1) v += __shfl_xor(v, o);
    return v;
}
typedef float f32x2_t __attribute__((ext_vector_type(2)));
typedef __bf16 bf16x2_t __attribute__((ext_vector_type(2)));
__device__ __forceinline__ unsigned pk2(float lo, float hi) { const f32x2_t v = {lo, hi}; const bf16x2_t b = __builtin_convertvector(v, bf16x2_t); return __builtin_bit_cast(unsigned, b); }
__device__ __forceinline__ float bflo(unsigned u) { return __builtin_bit_cast(float, u << 16); }
__device__ __forceinline__ float bfhi(unsigned u) { return __builtin_bit_cast(float, u & 0xffff0000u); }
__device__ __forceinline__ float bf1(bf16 h) { return __builtin_bit_cast(float, (unsigned)h << 16); }
__device__ __forceinline__ bf16 f2bf(float f) { return (bf16)(pk2(f, 0.f) & 0xffffu); }
__device__ __forceinline__ float frcp(float x) { return __builtin_amdgcn_rcpf(x); }
__device__ __forceinline__ float frsq(float x) { return __builtin_amdgcn_rsqf(x); }
__device__ __forceinline__ float sigmoidf_(float x) { return frcp(1.0f + __builtin_amdgcn_exp2f(-1.4426950408889634f * x)); }
__device__ __forceinline__ float gelu_tanh(float x) { const float u = 1.5957691216057308f * (x + 0.044715f * x * x * x); return x * frcp(1.0f + __builtin_amdgcn_exp2f(-1.4426950408889634f * u)); }
__device__ __forceinline__ float softplusf_(float x) { return x > 20.f ? x : log1pf(__expf(x)); }
__device__ __forceinline__ int crow(int i, int hi) { return (i & 3) + 8 * (i >> 2) + 4 * hi; }
#define MFMA32(a, b, c) __builtin_amdgcn_mfma_f32_32x32x16_bf16((a), (b), (c), 0, 0, 0)
__device__ __forceinline__ f32x16 zero16() { f32x16 z; for (int i = 0; i < 16; ++i) z[i] = 0.f; return z; }
__device__ __forceinline__ bf16x8 ld8(const bf16* p) { return *(const bf16x8*)p; }
__device__ __forceinline__ bf16x8 lds8(const LAS unsigned char* p) { return *(const LAS bf16x8*)p; }
#define LDS_FENCE() asm volatile("s_waitcnt lgkmcnt(0)" ::: "memory")

#define XB_TMO      128
#define XB_XCNT(j)  (256  + 64 * (j))
#define XB_XSUB(j)  (1280 + 64 * (j))
#define XB_XGEN(j)  (2304 + 64 * (j))
#define XB_TOP      3328
#define XB_TOPGEN   3392
#define XCD_BAR_WORDS 3456
#define XB_SPIN_CAP (1u << 22)
__device__ __forceinline__ unsigned xb_ld(unsigned* p)              { return __hip_atomic_load(p, __ATOMIC_RELAXED, __HIP_MEMORY_SCOPE_AGENT); }
__device__ __forceinline__ unsigned xb_add(unsigned* p, unsigned v) { return __hip_atomic_fetch_add(p, v, __ATOMIC_RELAXED, __HIP_MEMORY_SCOPE_AGENT); }
__device__ __forceinline__ unsigned xb_xcc_id() { return (unsigned)__builtin_amdgcn_s_getreg((3 << 11) | 20) & 0xFu; }
#define XB_SPIN(cond, bar) do { unsigned _sp = 0; while (cond) { __builtin_amdgcn_s_sleep(1); \
    if ((++_sp & 255u) == 0u) { if (xb_ld(&(bar)[XB_TMO])) break; if (_sp > XB_SPIN_CAP) { atomicAdd(&(bar)[XB_TMO], 1u); break; } } } } while (0)
struct XcdBarrier { unsigned* bar; unsigned x; volatile LAS unsigned* st; };
__device__ __forceinline__ XcdBarrier xcd_barrier_post(unsigned* bar, volatile LAS unsigned* st) {
    XcdBarrier b; b.bar = bar; b.x = xb_xcc_id(); b.st = st;
    if (threadIdx.x == 0) (void)xb_add(&bar[XB_XCNT(b.x)], 1u);
    return b;
}
__device__ __forceinline__ void xcd_barrier_complete(unsigned* bar, unsigned x, unsigned& nloc, unsigned& nx) {
    const unsigned G = gridDim.x * gridDim.y * gridDim.z;
    unsigned sum, cnt, mine, sp = 0u;
    for (;;) {
        sum = 0u; cnt = 0u; mine = 0u;
#pragma unroll
        for (unsigned j = 0; j < 16; ++j) { const unsigned c = xb_ld(&bar[XB_XCNT(j)]); sum += c; cnt += (c > 0u) ? 1u : 0u; mine = (j == x) ? c : mine; }
        if (sum == G) break;
        __builtin_amdgcn_s_sleep(1);
        if ((++sp & 255u) == 0u) { if (xb_ld(&bar[XB_TMO])) break; if (sp > XB_SPIN_CAP) { atomicAdd(&bar[XB_TMO], 1u); break; } }
    }
    nloc = mine > 0u ? mine : 1u; nx = cnt > 0u ? cnt : 1u;
}
__device__ __forceinline__ void xcd_barrier(const XcdBarrier& b) {
    asm volatile("s_waitcnt vmcnt(0)" ::: "memory");
    __syncthreads();
    if (threadIdx.x == 0) {
        unsigned* bar = b.bar;
        __builtin_amdgcn_s_waitcnt(0);
        unsigned nloc = b.st[0], nx = b.st[1];
        if (nloc == 0u) { xcd_barrier_complete(bar, b.x, nloc, nx); b.st[0] = nloc; b.st[1] = nx; }
        const unsigned old = xb_add(&bar[XB_XSUB(b.x)], 1u);
        const unsigned gen = old / nloc;
        if (old + 1u == (gen + 1u) * nloc) {
            __builtin_amdgcn_fence(__ATOMIC_RELEASE, "agent");
            asm volatile("s_waitcnt vmcnt(0)" ::: "memory");
            const unsigned og = xb_add(&bar[XB_TOP], 1u);
            const unsigned tg = og / nx;
            if (og + 1u == (tg + 1u) * nx) xb_add(&bar[XB_TOPGEN], 1u);
            else XB_SPIN(xb_ld(&bar[XB_TOPGEN]) == tg, bar);
            __builtin_amdgcn_fence(__ATOMIC_ACQUIRE, "agent");
            xb_add(&bar[XB_XGEN(b.x)], 1u);
            asm volatile("s_waitcnt vmcnt(0)" ::: "memory");
        } else {
            XB_SPIN(xb_ld(&bar[XB_XGEN(b.x)]) == gen, bar);
            __builtin_amdgcn_fence(__ATOMIC_ACQUIRE, "agent");
            asm volatile("s_waitcnt vmcnt(0)" ::: "memory");
        }
    }
    __syncthreads();
}

struct Frame {
    LAS unsigned char* lds;
    __attribute__((address_space(1))) unsigned char* ws;
    int tid, lane, wave, vcu, G, gw, NGW;
};

__device__ __forceinline__ Frame launder(const Frame& F) {
    Frame G = F; asm volatile("" : "+s"(G.ws)); int t = G.tid; asm volatile("" : "+v"(t)); t &= 511; G.tid = t; G.lane = t & 63; int w = G.wave; asm volatile("" : "+s"(w)); G.wave = w & 7; return G; }
__device__ __forceinline__ int launder_i(int v) { asm volatile("" : "+s"(v)); return v; }
template <bool F8>
__device__ __forceinline__ void tr_item(const float* W, int K, int ldn, int c0, bf16* WT, int r0, int nblk, LAS float* scr, int item, int lane) {
    const int kb = item / nblk, nb = item % nblk, k0 = 64 * kb, n0 = 64 * nb;
    const int lr = lane >> 4, lc = (lane & 15) * 4;
#pragma unroll 8
    for (int i = 0; i < 16; ++i) { const int kk = 4 * i + lr; const f32x4 v = *(const f32x4*)(W + (size_t)(k0 + kk) * ldn + c0 + n0 + lc);
        LAS float* s = scr + kk * 65 + lc; s[0] = v.x; s[1] = v.y; s[2] = v.z; s[3] = v.w; }
    LDS_FENCE();
    const int c = lane & 7;
#pragma unroll
    for (int j = 0; j < 8; ++j) { const int n = (lane >> 3) + 8 * j; const LAS float* s = scr + (8 * c) * 65 + n;
        if constexpr (F8) { u32x2 o; o.x = pk4_fp8(64.f * s[0 * 65], 64.f * s[1 * 65], 64.f * s[2 * 65], 64.f * s[3 * 65]); o.y = pk4_fp8(64.f * s[4 * 65], 64.f * s[5 * 65], 64.f * s[6 * 65], 64.f * s[7 * 65]);
            *(u32x2*)((unsigned char*)WT + (size_t)(r0 + n0 + n) * K + k0 + 8 * c) = o; }
        else { u32x4 o; o.x = pk2(s[0 * 65], s[1 * 65]); o.y = pk2(s[2 * 65], s[3 * 65]); o.z = pk2(s[4 * 65], s[5 * 65]); o.w = pk2(s[6 * 65], s[7 * 65]);
            *(u32x4*)(WT + (size_t)(r0 + n0 + n) * K + k0 + 8 * c) = o; } }
    LDS_FENCE();
}
template <bool F8 = false>
__device__ __forceinline__ void tr_matrix(const Frame& F, const float* W, int K, int ldn, int c0, int ncols, bf16* WT, int r0, int rot) {
    LAS float* scr = (LAS float*)(F.lds + F.wave * 16640);
    const int nblk = ncols / 64, nitems = (K / 64) * nblk;
    int start = F.gw - (rot % F.NGW); if (start < 0) start += F.NGW;
    for (int it = start; it < nitems; it += F.NGW) tr_item<F8>(W, K, ldn, c0, WT, r0, nblk, scr, it, F.lane);
}
template <bool F8 = false>
__device__ __forceinline__ void rms_rows(const Frame& F, const float* x, const float* g, bf16* o, unsigned char* o8 = nullptr) {
    f32x4 gg[4];
#pragma unroll
    for (int j = 0; j < 4; ++j) gg[j] = ((const f32x4*)g)[F.lane + 64 * j];
    for (int m0 = F.gw; m0 < MT; m0 += 2 * F.NGW) {
        const int m1 = m0 + F.NGW; const bool has1 = m1 < MT;
        const f32x4* xr0 = (const f32x4*)(x + (size_t)m0 * DM) + F.lane; const f32x4* xr1 = (const f32x4*)(x + (size_t)(has1 ? m1 : m0) * DM) + F.lane;
        f32x4 v0[4], v1[4]; float s0 = 0.f, s1 = 0.f;
#pragma unroll
        for (int j = 0; j < 4; ++j) { v0[j] = xr0[64 * j]; v1[j] = xr1[64 * j]; }
#pragma unroll
        for (int j = 0; j < 4; ++j) { s0 += (v0[j].x * v0[j].x + v0[j].y * v0[j].y) + (v0[j].z * v0[j].z + v0[j].w * v0[j].w); s1 += (v1[j].x * v1[j].x + v1[j].y * v1[j].y) + (v1[j].z * v1[j].z + v1[j].w * v1[j].w); }
#pragma unroll
        for (int of = 1; of < 64; of <<= 1) { s0 += __shfl_xor(s0, of); s1 += __shfl_xor(s1, of); }
        const float sc0 = frsq(s0 * (1.0f / DM) + EPS), sc1 = frsq(s1 * (1.0f / DM) + EPS);
        u32x2* o0 = (u32x2*)(o + (size_t)m0 * DM) + F.lane; u32x2* o1 = (u32x2*)(o + (size_t)m1 * DM) + F.lane;
#pragma unroll
        for (int j = 0; j < 4; ++j) {
            u32x2 w; w.x = pk2(v0[j].x * sc0 * gg[j].x, v0[j].y * sc0 * gg[j].y); w.y = pk2(v0[j].z * sc0 * gg[j].z, v0[j].w * sc0 * gg[j].w); o0[64 * j] = w;
            if constexpr (F8) ((unsigned*)(o8 + (size_t)m0 * DM))[F.lane + 64 * j] = pk4_fp8(v0[j].x * sc0 * gg[j].x, v0[j].y * sc0 * gg[j].y, v0[j].z * sc0 * gg[j].z, v0[j].w * sc0 * gg[j].w);
            if (has1) { u32x2 w1; w1.x = pk2(v1[j].x * sc1 * gg[j].x, v1[j].y * sc1 * gg[j].y); w1.y = pk2(v1[j].z * sc1 * gg[j].z, v1[j].w * sc1 * gg[j].w); o1[64 * j] = w1;
                if constexpr (F8) ((unsigned*)(o8 + (size_t)m1 * DM))[F.lane + 64 * j] = pk4_fp8(v1[j].x * sc1 * gg[j].x, v1[j].y * sc1 * gg[j].y, v1[j].z * sc1 * gg[j].z, v1[j].w * sc1 * gg[j].w); } }
    }
}
__device__ __forceinline__ void phase_prep(const Frame& F, const Params& P, int layer) {
    unsigned char* ws = (unsigned char*)F.ws;
    const float* w_in = P.in[3] + (size_t)layer * DM * INCOLS;
    bf16* WIN = (bf16*)(ws + WS_WIN); bf16* WMRG = (bf16*)(ws + WS_WMRG);
    int rot = 0;
    tr_matrix(F, w_in, 1024, INCOLS, 3888, 1024, WIN, 0, rot); rot += 256;
    tr_matrix(F, w_in, 1024, INCOLS, 4912, 1536, WIN, 1024, rot); rot += 384;
    tr_matrix(F, w_in, 1024, INCOLS, 1840, 1024, WIN, WB_ROW0, rot); rot += 256;
    tr_matrix(F, w_in, 1024, INCOLS, 2864, 1024, WIN, WB_ROW0 + 1024, rot); rot += 256;
    tr_matrix(F, w_in, 1024, INCOLS, 0, 1024, WIN, WC_ROW0, rot); rot += 256;
    tr_matrix(F, w_in, 1024, INCOLS, 1024, 768, WIN, WC_ROW0 + 1024, rot); rot += 192;
    tr_matrix<true>(F, w_in, 1024, INCOLS, 6464, 3072, WMRG, 0, rot); rot += 768;
    for (int b = 0; b < 3; ++b) { tr_matrix<true>(F, P.in[25] + ((size_t)layer * 3 + b) * DM * DM, 1024, 1024, 0, 1024, WMRG, 3072 + 1024 * b, rot); rot += 256; }
    tr_matrix(F, P.in[26] + (size_t)layer * DM * DM, 1024, 1024, 0, 1024, (bf16*)(ws + WS_WOUT), 0, rot); rot += 256;
    tr_matrix(F, P.in[28] + (size_t)layer * DM * 2048, 1024, 2048, 0, 2048, (bf16*)(ws + WS_WQ), 0, rot); rot += 512;
    tr_matrix(F, P.in[8] + (size_t)layer * 2048 * 256, 2048, 256, 0, 256, (bf16*)(ws + WS_W1K), 0, rot); rot += 128;
    tr_matrix(F, P.in[10] + (size_t)layer * 2048 * 256, 2048, 256, 0, 256, (bf16*)(ws + WS_W1V), 0, rot); rot += 128;
    tr_matrix(F, P.in[9] + (size_t)layer * 256 * 64, 256, 64, 0, 64, (bf16*)(ws + WS_W2K), 0, rot); rot += 4;
    tr_matrix(F, P.in[11] + (size_t)layer * 256 * 64, 256, 64, 0, 64, (bf16*)(ws + WS_W2V), 0, rot); rot += 4;
    for (int h = 0; h < 16; ++h) {
        tr_matrix(F, P.in[14] + ((size_t)layer * 16 + h) * 4096, 64, 64, 0, 64, (bf16*)(ws + WS_WRT) + h * 4096, 0, rot); rot += 1;
        tr_matrix(F, P.in[16] + ((size_t)layer * 16 + h) * 4096, 64, 64, 0, 64, (bf16*)(ws + WS_WIT) + h * 4096, 0, rot); rot += 1;
    }
    const int gt = F.vcu * NTHREADS + F.tid, NGT = F.G * NTHREADS;
    for (int e = gt; e < 256 * 1024; e += NGT) {
        const int n = e >> 10, k = e & 1023; float v = 0.f;
        if (n < 16) v = w_in[(size_t)k * INCOLS + 6448 + n]; else if (n < 64) v = w_in[(size_t)k * INCOLS + 1792 + (n - 16)];
        WIN[(size_t)(2560 + n) * 1024 + k] = f2bf(v);
    }
    { const float* sk = P.in[29] + (size_t)layer * 262144; bf16* o = (bf16*)(ws + WS_SK);
      for (int e = gt; e < 262144; e += NGT) o[e] = f2bf(sk[e]); }
    const float* xin = layer == 0 ? P.in[0] : P.out;
    rms_rows<true>(F, xin, P.in[2] + (size_t)layer * DM, (bf16*)(ws + WS_XN), ws + WS_XN8);
}

struct Seg3 { bf16* p0; int ld0, t0; bf16* p1; int ld1, t1; bf16* p2; int ld2, t2; bf16* p3; int ld3; };
struct EpiSeg {
    static constexpr bool PERM = true, AFTER_DRAIN = false;
    Seg3 s;
    __device__ __forceinline__ void operator()(const pg8::f32x4 (&acc)[2][2][4][2], const pg8::Unit& u, int wr, int wc, int fr, int fq) const {
        bf16* base; int ld, ct;
        if (u.pn < s.t0) { base = s.p0; ld = s.ld0; ct = u.pn; } else if (u.pn < s.t1) { base = s.p1; ld = s.ld1; ct = u.pn - s.t0; } else if (u.pn < s.t2) { base = s.p2; ld = s.ld2; ct = u.pn - s.t1; } else { base = s.p3; ld = s.ld3; ct = u.pn - s.t2; }
        const int row0 = u.pm * 256 + wr * 64 + fr, col0 = ct * 256 + wc * 32 + 8 * fq;
#pragma unroll
        for (int ai = 0; ai < 2; ++ai)
#pragma unroll
            for (int m = 0; m < 4; ++m) { bf16* rowp = base + (size_t)(row0 + ai * 128 + m * 16) * ld + col0;
#pragma unroll
                for (int bj = 0; bj < 2; ++bj) { const pg8::f32x4 v0 = acc[ai][bj][m][0], v1 = acc[ai][bj][m][1];
                    u32x4 w; w.x = pk2(v0[0], v0[1]); w.y = pk2(v0[2], v0[3]); w.z = pk2(v1[0], v1[1]); w.w = pk2(v1[2], v1[3]);
                    *(u32x4*)(rowp + bj * 128) = w; } }
    }
};
struct EpiResid {
    static constexpr bool PERM = true, AFTER_DRAIN = false;
    const float* xres; float* out; bool dry;
    __device__ __forceinline__ void operator()(const pg8::f32x4 (&acc)[2][2][4][2], const pg8::Unit& u, int wr, int wc, int fr, int fq) const {
        const int row0 = u.pm * 256 + wr * 64 + fr, col0 = u.pn * 256 + wc * 32 + 8 * fq;
#pragma unroll
        for (int ai = 0; ai < 2; ++ai)
#pragma unroll
            for (int m = 0; m < 4; ++m) { const size_t off = (size_t)(row0 + ai * 128 + m * 16) * DM + col0;
#pragma unroll
                for (int bj = 0; bj < 2; ++bj) {
                    const f32x4 x0 = *(const f32x4*)(xres + off + bj * 128), x1 = *(const f32x4*)(xres + off + bj * 128 + 4);
                    const pg8::f32x4 v0 = acc[ai][bj][m][0], v1 = acc[ai][bj][m][1];
                    f32x4 o0, o1; o0.x = x0.x + v0[0]; o0.y = x0.y + v0[1]; o0.z = x0.z + v0[2]; o0.w = x0.w + v0[3];
                    o1.x = x1.x + v1[0]; o1.y = x1.y + v1[1]; o1.z = x1.z + v1[2]; o1.w = x1.w + v1[3];
                    if (!dry) { *(f32x4*)(out + off + bj * 128) = o0; *(f32x4*)(out + off + bj * 128 + 4) = o1; } } }
    }
};
constexpr int MRG_NEN = ((DBG_BRANCH >> 0) & 1) + ((DBG_BRANCH >> 1) & 1) + ((DBG_BRANCH >> 2) & 1);
__host__ __device__ constexpr int mrg_branch(int k) {
    int c = 0; for (int b = 0; b < 3; ++b) if ((DBG_BRANCH >> b) & 1) { if (c == k) return b; ++c; } return 0;
}
__host__ __device__ constexpr int mrg_atile(int b) { return b == 0 ? A8_TILE(WS_YA8) : (b == 1 ? A8_TILE(WS_YB8) : A8_TILE(WS_YC8)); }
struct MergeOrder {
    int G, c;
    __device__ __forceinline__ bool next(int i, pg8::Unit& u) const {
        constexpr int NSUB = 2 * MRG_NEN;
        const int tile = (i / NSUB) * G + c; if (tile >= 512) return false;
        const int sub = i % NSUB, k = sub >> 1, b = (k == 0) ? mrg_branch(0) : (k == 1 ? mrg_branch(1) : mrg_branch(2));
        const int tm = tile >> 2, tn = tile & 3;
        if (sub & 1) { u.pm = mrg_atile(b) + tm; u.pn = 12 + 4 * b + tn; } else { u.pm = A8_TILE(WS_XN8) + tm; u.pn = 4 * b + tn; }
        return true;
    }
    __device__ __forceinline__ void a_ready(const pg8::Unit&) const {}
    __device__ __forceinline__ void done(const pg8::Unit&) const {}
};
struct EpiMerge {
    static constexpr bool PERM = true, AFTER_DRAIN = false;
    unsigned char* gbuf; unsigned char* mbuf; bf16* merged;
    __device__ __forceinline__ void operator()(const pg8::f32x4 (&acc)[2][2][4][2], const pg8::Unit& u, int wr, int wc, int fr, int fq) const {
        const int tid = threadIdx.x;
        const bool isbr = u.pn >= 12;
        const __amdgpu_buffer_rsrc_t grs = __builtin_amdgcn_make_buffer_rsrc((void*)gbuf, 0, 131072, 0x00020000);
        const __amdgpu_buffer_rsrc_t mrs = __builtin_amdgcn_make_buffer_rsrc((void*)mbuf, 0, 131072, 0x00020000);
        int vo_ = tid * 16; asm volatile("" : "+v"(vo_)); const int vo = vo_;
        if (!isbr) {
#pragma unroll
            for (int q = 0; q < 16; ++q) { const int ai = q >> 3, m = (q >> 1) & 3, bj = q & 1;
                const pg8::f32x4 v0 = acc[ai][bj][m][0], v1 = acc[ai][bj][m][1];
                u32x4 w; w.x = pk2(sigmoidf_(v0[0]), sigmoidf_(v0[1])); w.y = pk2(sigmoidf_(v0[2]), sigmoidf_(v0[3]));
                w.z = pk2(sigmoidf_(v1[0]), sigmoidf_(v1[1])); w.w = pk2(sigmoidf_(v1[2]), sigmoidf_(v1[3]));
                int so = vo + q * 8192; asm volatile("" : "+v"(so));
                __builtin_amdgcn_raw_buffer_store_b128(w, grs, so, 0, 0); }
        } else {
            const int b = (u.pn - 12) >> 2, tm = u.pm - (b == 0 ? mrg_atile(0) : (b == 1 ? mrg_atile(1) : mrg_atile(2))), tn = u.pn & 3;
            const bool first = (b == mrg_branch(0)), last = (b == mrg_branch(MRG_NEN - 1));
            const int row0 = tm * 256 + wr * 64 + fr, col0 = tn * 256 + wc * 32 + 8 * fq;
#pragma unroll
            for (int hb = 0; hb < 2; ++hb) {
                u32x4 gw[8], pv[8];
#pragma unroll
                for (int k = 0; k < 8; ++k) gw[k] = __builtin_bit_cast(u32x4, __builtin_amdgcn_raw_buffer_load_b128(grs, vo, (8 * hb + k) * 8192, 0));
                if (!first) {
#pragma unroll
                    for (int k = 0; k < 8; ++k) pv[k] = __builtin_bit_cast(u32x4, __builtin_amdgcn_raw_buffer_load_b128(mrs, vo, (8 * hb + k) * 8192, 0)); }
#pragma unroll
                for (int k = 0; k < 8; ++k) { const int q = 8 * hb + k, ai = q >> 3, m = (q >> 1) & 3, bj = q & 1;
                    const pg8::f32x4 v0 = acc[ai][bj][m][0], v1 = acc[ai][bj][m][1];
                    f32x4 r0, r1;
                    r0.x = v0[0] * bflo(gw[k].x); r0.y = v0[1] * bfhi(gw[k].x); r0.z = v0[2] * bflo(gw[k].y); r0.w = v0[3] * bfhi(gw[k].y);
                    r1.x = v1[0] * bflo(gw[k].z); r1.y = v1[1] * bfhi(gw[k].z); r1.z = v1[2] * bflo(gw[k].w); r1.w = v1[3] * bfhi(gw[k].w);
                    if (!first) { r0.x += bflo(pv[k].x); r0.y += bfhi(pv[k].x); r0.z += bflo(pv[k].y); r0.w += bfhi(pv[k].y); r1.x += bflo(pv[k].z); r1.y += bfhi(pv[k].z); r1.z += bflo(pv[k].w); r1.w += bfhi(pv[k].w); }
                    u32x4 w; w.x = pk2(r0.x, r0.y); w.y = pk2(r0.z, r0.w); w.z = pk2(r1.x, r1.y); w.w = pk2(r1.z, r1.w);
                    if (last) *(u32x4*)(merged + (size_t)(row0 + ai * 128 + m * 16) * DM + col0 + bj * 128) = w;
                    else { int so = vo + q * 8192; asm volatile("" : "+v"(so)); __builtin_amdgcn_raw_buffer_store_b128(w, mrs, so, 0, 0); } }
                asm volatile("" ::: "memory");
            }
        }
    }
};

__device__ __forceinline__ void phase_s0(const Frame& F, const Params& P, int layer) {
    unsigned char* ws = (unsigned char*)F.ws;
    const bf16* raw = (const bf16*)(ws + WS_XBC); const bf16* misc = (const bf16*)(ws + WS_MISC);
    bf16* XT = (bf16*)(ws + WS_XT); bf16* BM = (bf16*)(ws + WS_BM); bf16* CM = (bf16*)(ws + WS_CM); bf16* BT = (bf16*)(ws + WS_BT);
    float* DTV = (float*)(ws + WS_DTV);
    const float* cw = P.in[19] + (size_t)layer * 4 * 1536; const float* cb = P.in[20] + (size_t)layer * 1536;
    const float* dtb = P.in[21] + layer * 16;
    LAS bf16* tile = (LAS bf16*)F.lds;
    const int tl = F.tid >> 3, cg = F.tid & 7;
    const int per_wg = (NB * 128 * 12 + F.G - 1) / F.G, i0 = F.vcu * per_wg, i1 = min(NB * 128 * 12, i0 + per_wg);
    f32x4 wgt[2][10]; int wct = -1;
    u32x4 xn[2][4];
#define S0_ISSUE(idx_) do { const int ct2_ = (idx_) >> 9, tok_ = (idx_) & 511, t_ = (tok_ & 127) * 64 + tl; _Pragma("unroll") for (int h2 = 0; h2 < 2; ++h2) { const int ch0 = (ct2_ + 12 * h2) * 64 + cg * 8; \
        _Pragma("unroll") for (int k = 0; k < 4; ++k) { const int ts = t_ - 3 + k; const u32x4 v_ = *(const u32x4*)(raw + (size_t)((tok_ >> 7) * SEQ + (ts < 0 ? 0 : ts)) * 1536 + ch0); xn[h2][k] = (ts >= 0) ? v_ : (u32x4){0u, 0u, 0u, 0u}; } } } while (0)
    if (i0 < i1) S0_ISSUE(i0);
#pragma unroll 1
    for (int idx = i0; idx < i1; ++idx) {
        const int ct2 = idx >> 9, tok = idx & 511, b = tok >> 7, tt = tok & 127;
        const int t = tt * 64 + tl;
        LAS bf16* tbuf = tile + (idx & 1) * 8192;
        if (ct2 != wct) { wct = ct2;
#pragma unroll
            for (int h2 = 0; h2 < 2; ++h2) { const int ch0 = (ct2 + 12 * h2) * 64 + cg * 8;
#pragma unroll
                for (int k = 0; k < 4; ++k) { wgt[h2][2 * k] = *(const f32x4*)(cw + k * 1536 + ch0); wgt[h2][2 * k + 1] = *(const f32x4*)(cw + k * 1536 + ch0 + 4); }
                wgt[h2][8] = *(const f32x4*)(cb + ch0); wgt[h2][9] = *(const f32x4*)(cb + ch0 + 4); } }
        u32x4 xr[2][4];
#pragma unroll
        for (int h2 = 0; h2 < 2; ++h2)
#pragma unroll
            for (int k = 0; k < 4; ++k) xr[h2][k] = xn[h2][k];
        if (idx + 1 < i1) S0_ISSUE(idx + 1);
#pragma unroll
        for (int h2 = 0; h2 < 2; ++h2) { const int ct = ct2 + 12 * h2, ch0 = ct * 64 + cg * 8;
            float o[8] = {wgt[h2][8].x, wgt[h2][8].y, wgt[h2][8].z, wgt[h2][8].w, wgt[h2][9].x, wgt[h2][9].y, wgt[h2][9].z, wgt[h2][9].w};
#pragma unroll
            for (int k = 0; k < 4; ++k) { const u32x4 x = xr[h2][k]; const f32x4 w0 = wgt[h2][2 * k], w1 = wgt[h2][2 * k + 1];
                o[0] += bflo(x.x) * w0.x; o[1] += bfhi(x.x) * w0.y; o[2] += bflo(x.y) * w0.z; o[3] += bfhi(x.y) * w0.w;
                o[4] += bflo(x.z) * w1.x; o[5] += bfhi(x.z) * w1.y; o[6] += bflo(x.w) * w1.z; o[7] += bfhi(x.w) * w1.w; }
#pragma unroll
            for (int e = 0; e < 8; ++e) o[e] = o[e] * sigmoidf_(o[e]);
            if (ct >= 16) {
                u32x4 pw; pw.x = pk2(o[0], o[1]); pw.y = pk2(o[2], o[3]); pw.z = pk2(o[4], o[5]); pw.w = pk2(o[6], o[7]);
                bf16* dst = (ct < 20) ? BM : CM; const int col = ch0 - ((ct < 20) ? 1024 : 1280);
                *(u32x4*)(dst + (size_t)(b * SEQ + t) * 256 + col) = pw;
            }
            if (ct < 20) {
#pragma unroll
                for (int e = 0; e < 8; ++e) tbuf[h2 * 4096 + (cg * 8 + e) * 64 + ((((tl >> 3) ^ cg) << 3) | (tl & 7))] = f2bf(o[e]);
            }
        }
        __syncthreads();
#pragma unroll
        for (int h2 = 0; h2 < 2; ++h2) { const int ct = ct2 + 12 * h2;
            if (ct < 20) {
                const int r = F.tid >> 3, chk = F.tid & 7;
                const u32x4 v = *(const LAS u32x4*)(tbuf + h2 * 4096 + r * 64 + ((chk ^ ((r >> 3) & 7)) << 3));
                bf16* dst = (ct < 16) ? (XT + ((size_t)b * 1024 + ct * 64 + r) * SEQ) : (BT + ((size_t)b * 256 + (ct - 16) * 64 + r) * SEQ);
                *(u32x4*)(dst + tt * 64 + chk * 8) = v;
            }
        }
    }
#undef S0_ISSUE
    __syncthreads();
    const int gt = F.vcu * NTHREADS + F.tid, NGT = F.G * NTHREADS;
    for (int e = gt; e < MT * 16; e += NGT) { const int m = e >> 4, h = e & 15; DTV[e] = softplusf_(bf1(misc[(size_t)m * 256 + h]) + dtb[h]); }
}

__device__ __forceinline__ float ssd_chunk_scan(const float* DTV, int b, int t0, int hh, float A, int lane, LAS float* acs, LAS float* dts) {
    const float dt0 = DTV[(size_t)(b * SEQ + t0 + lane) * 16 + hh], dt1 = DTV[(size_t)(b * SEQ + t0 + 64 + lane) * 16 + hh];
    float x0 = dt0 * A, x1 = dt1 * A;
#pragma unroll
    for (int o = 1; o < 64; o <<= 1) { const float y0 = __shfl_up(x0, o), y1 = __shfl_up(x1, o); if (lane >= o) { x0 += y0; x1 += y1; } }
    const float tot0 = __shfl(x0, 63); x1 += tot0;
    const float aend = __shfl(x1, 63);
    acs[lane] = x0; acs[lane + 64] = x1; dts[lane] = dt0; dts[lane + 64] = dt1;
    LDS_FENCE();
    return aend;
}

__device__ __forceinline__ void phase_s1(const Frame& F, const Params& P, int layer) {
    unsigned char* ws = (unsigned char*)F.ws;
    const bf16* XT = (const bf16*)(ws + WS_XT); const bf16* BT = (const bf16*)(ws + WS_BT); const float* DTV = (const float*)(ws + WS_DTV);
    bf16* ST = (bf16*)(ws + WS_STATES); float* DEC = (float*)(ws + WS_DEC);
    const float* alog = P.in[22] + layer * 16;
    LAS float* acs = (LAS float*)(F.lds) + F.wave * 256; LAS float* dts = acs + 128;
    const int lane = F.lane, hi = lane >> 5, l31 = lane & 31;
    for (int u = F.vcu; u < NB * 64 * 2; u += F.G) {
        const int g = u & 1, c = (u >> 1) & 63, b = u >> 7, hh = g * 8 + F.wave, t0 = c * 128;
        const float A = -__expf(alog[hh]);
        const float aend = ssd_chunk_scan(DTV, b, t0, hh, A, lane, acs, dts);
        if (lane == 0) DEC[(b * 64 + c) * 16 + hh] = __expf(aend);
        f32x16 acc[2][4];
#pragma unroll
        for (int i = 0; i < 2; ++i)
#pragma unroll
            for (int j = 0; j < 4; ++j) acc[i][j] = zero16();
#pragma unroll 4
        for (int ks = 0; ks < 8; ++ks) {
            const int l0 = 16 * ks + 8 * hi;
            float wv[8];
#pragma unroll
            for (int e = 0; e < 8; ++e) wv[e] = dts[l0 + e] * __expf(aend - acs[l0 + e]);
            bf16x8 af[2], bfr[4];
#pragma unroll
            for (int pt = 0; pt < 2; ++pt) {
                const u32x4 xr = *(const u32x4*)(XT + ((size_t)b * 1024 + hh * 64 + pt * 32 + l31) * SEQ + t0 + l0);
                u32x4 o; o.x = pk2(bflo(xr.x) * wv[0], bfhi(xr.x) * wv[1]); o.y = pk2(bflo(xr.y) * wv[2], bfhi(xr.y) * wv[3]);
                o.z = pk2(bflo(xr.z) * wv[4], bfhi(xr.z) * wv[5]); o.w = pk2(bflo(xr.w) * wv[6], bfhi(xr.w) * wv[7]);
                af[pt] = __builtin_bit_cast(bf16x8, o);
            }
#pragma unroll
            for (int nt = 0; nt < 4; ++nt) bfr[nt] = ld8(BT + ((size_t)b * 256 + g * 128 + nt * 32 + l31) * SEQ + t0 + l0);
#pragma unroll
            for (int pt = 0; pt < 2; ++pt)
#pragma unroll
                for (int nt = 0; nt < 4; ++nt) acc[pt][nt] = MFMA32(bfr[nt], af[pt], acc[pt][nt]);
        }
        bf16* sp = ST + ((size_t)((b * 64 + c) * 16 + hh)) * 8192;
#pragma unroll
        for (int pt = 0; pt < 2; ++pt)
#pragma unroll
            for (int nt = 0; nt < 4; ++nt)
#pragma unroll
                for (int q = 0; q < 4; ++q) { u32x2 o; o.x = pk2(acc[pt][nt][4 * q], acc[pt][nt][4 * q + 1]); o.y = pk2(acc[pt][nt][4 * q + 2], acc[pt][nt][4 * q + 3]);
                    *(u32x2*)(sp + (pt * 32 + l31) * 128 + nt * 32 + 8 * q + 4 * hi) = o; }
        LDS_FENCE();
    }
}

__device__ __forceinline__ void phase_s2(const Frame& F, const bool dry) {
    unsigned char* ws = (unsigned char*)F.ws;
    bf16* ST = (bf16*)(ws + WS_STATES); const float* DEC = (const float*)(ws + WS_DEC);
    const int gt = F.vcu * NTHREADS + F.tid, NGT = F.G * NTHREADS;
    for (int e = gt; e < NB * 16 * 2048; e += NGT) {
        const int b = e / 32768, rem = e % 32768, hh = rem / 2048, pn = rem % 2048;
        float run[4] = {0.f, 0.f, 0.f, 0.f};
        for (int c0 = 0; c0 < 64; c0 += 8) {
            u32x2 s[8]; float d[8];
#pragma unroll
            for (int k = 0; k < 8; ++k) { s[k] = *(const u32x2*)(ST + ((size_t)((b * 64 + c0 + k) * 16 + hh)) * 8192 + pn * 4); d[k] = DEC[(b * 64 + c0 + k) * 16 + hh]; }
#pragma unroll
            for (int k = 0; k < 8; ++k) {
                u32x2 o; o.x = pk2(run[0], run[1]); o.y = pk2(run[2], run[3]);
                if (!dry) *(u32x2*)(ST + ((size_t)((b * 64 + c0 + k) * 16 + hh)) * 8192 + pn * 4) = o;
                run[0] = run[0] * d[k] + bflo(s[k].x); run[1] = run[1] * d[k] + bfhi(s[k].x); run[2] = run[2] * d[k] + bflo(s[k].y); run[3] = run[3] * d[k] + bfhi(s[k].y);
            }
        }
    }
}

constexpr int S3_CT = 0, S3_BT = 34816, S3_Y = 69632, S3_ACS = S3_Y + 8 * 8320, S3_SSQ = S3_ACS + 8 * 1024;
__device__ __forceinline__ void phase_s3(const Frame& F, const Params& P, int layer, const bool dry) {
    unsigned char* ws = (unsigned char*)F.ws;
    const bf16* XT = (const bf16*)(ws + WS_XT); const bf16* BM = (const bf16*)(ws + WS_BM); const bf16* CM = (const bf16*)(ws + WS_CM);
    const float* DTV = (const float*)(ws + WS_DTV); const bf16* ST = (const bf16*)(ws + WS_STATES);
    bf16* YC = (bf16*)(ws + WS_YC); unsigned char* YC8 = ws + WS_YC8;
    const float* alog = P.in[22] + layer * 16; const float* dsk = P.in[23] + layer * 16; const float* ng = P.in[24] + (size_t)layer * 1024;
    LAS unsigned char* Ct = F.lds + S3_CT; LAS unsigned char* Bt = F.lds + S3_BT;
    LAS float* Y = (LAS float*)(F.lds + S3_Y + F.wave * 8320);
    LAS float* acs = (LAS float*)(F.lds + S3_ACS) + F.wave * 256; LAS float* dts = acs + 128;
    LAS float* ssq = (LAS float*)(F.lds + S3_SSQ);
    const int lane = F.lane, hi = lane >> 5, l31 = lane & 31;
    for (int u = F.vcu; u < NB * 64 * 2; u += F.G) {
        const int g = u & 1, c = (u >> 1) & 63, b = u >> 7, hh = g * 8 + F.wave, t0 = c * 128;
#pragma unroll
        for (int k = 0; k < 4; ++k) { const int idx = F.tid + k * NTHREADS, r = idx >> 4, ch = idx & 15;
            const u32x4 vc = *(const u32x4*)(CM + (size_t)(b * SEQ + t0 + r) * 256 + g * 128 + ch * 8);
            const u32x4 vb = *(const u32x4*)(BM + (size_t)(b * SEQ + t0 + r) * 256 + g * 128 + ch * 8);
            *(LAS u32x4*)(Ct + r * 272 + ch * 16) = vc; *(LAS u32x4*)(Bt + r * 272 + ch * 16) = vb; }
        const float A = -__expf(alog[hh]);
        (void)ssd_chunk_scan(DTV, b, t0, hh, A, lane, acs, dts);
        const float Dh = dsk[hh];
        __syncthreads();
        const bf16* sin = ST + ((size_t)((b * 64 + c) * 16 + hh)) * 8192;
        bf16x8 sfr[2][8];
#pragma unroll
        for (int pt = 0; pt < 2; ++pt)
#pragma unroll
            for (int ks = 0; ks < 8; ++ks) sfr[pt][ks] = ld8(sin + (pt * 32 + l31) * 128 + 16 * ks + 8 * hi);
        for (int lt = 0; lt < 4; ++lt) {
            f32x16 acc[2] = {zero16(), zero16()};
            const int lcol = 32 * lt + l31;
#pragma unroll
            for (int ks = 0; ks < 8; ++ks) {
                const bf16x8 cf = lds8(Ct + lcol * 272 + (16 * ks + 8 * hi) * 2);
#pragma unroll
                for (int pt = 0; pt < 2; ++pt) acc[pt] = MFMA32(sfr[pt][ks], cf, acc[pt]);
            }
            const float acl = acs[lcol], el = __expf(acl);
#pragma unroll
            for (int pt = 0; pt < 2; ++pt)
#pragma unroll
                for (int i = 0; i < 16; ++i) acc[pt][i] *= el;
            for (int st = 0; st <= lt; ++st) {
                f32x16 cb = zero16();
#pragma unroll
                for (int ks = 0; ks < 8; ++ks) {
                    const bf16x8 bfm = lds8(Bt + (32 * st + l31) * 272 + (16 * ks + 8 * hi) * 2);
                    const bf16x8 cf = lds8(Ct + lcol * 272 + (16 * ks + 8 * hi) * 2);
                    cb = MFMA32(bfm, cf, cb);
                }
                float mv[16];
#pragma unroll
                for (int q = 0; q < 4; ++q) {
                    const int s0 = 32 * st + 8 * q + 4 * hi;
                    const f32x4 as4 = *(const LAS f32x4*)(acs + s0), dt4 = *(const LAS f32x4*)(dts + s0);
#pragma unroll
                    for (int e = 0; e < 4; ++e) { const int s = s0 + e; float v = 0.f;
                        if (s <= lcol) v = cb[4 * q + e] * __expf(acl - as4[e]) * dt4[e];
                        if (s == lcol) v += Dh;
                        mv[4 * q + e] = v; }
                }
#pragma unroll
                for (int k2 = 0; k2 < 2; ++k2) {
                    u32x4 pw; pw.x = pk2(mv[8 * k2 + 0], mv[8 * k2 + 1]); pw.y = pk2(mv[8 * k2 + 2], mv[8 * k2 + 3]);
                    pw.z = pk2(mv[8 * k2 + 4], mv[8 * k2 + 5]); pw.w = pk2(mv[8 * k2 + 6], mv[8 * k2 + 7]);
                    const bf16x8 pf = __builtin_bit_cast(bf16x8, pw);
#pragma unroll
                    for (int pt = 0; pt < 2; ++pt) {
                        const bf16* xp = XT + ((size_t)b * 1024 + hh * 64 + pt * 32 + l31) * SEQ + t0 + 32 * st + 16 * k2 + 4 * hi;
                        const u32x2 x0 = *(const u32x2*)xp, x1 = *(const u32x2*)(xp + 8);
                        u32x4 xa; xa.x = x0.x; xa.y = x0.y; xa.z = x1.x; xa.w = x1.y;
                        acc[pt] = MFMA32(__builtin_bit_cast(bf16x8, xa), pf, acc[pt]);
                    }
                }
            }
#pragma unroll
            for (int pt = 0; pt < 2; ++pt)
#pragma unroll
                for (int i = 0; i < 16; ++i) Y[l31 * 65 + pt * 32 + crow(i, hi)] = acc[pt][i];
            LDS_FENCE();
            const int tl = lane >> 1, ph = lane & 1, t = t0 + 32 * lt + tl;
            bf16* zp = YC + (size_t)(b * SEQ + t) * 1024 + hh * 64 + ph * 32;
            float v[32]; float sq = 0.f;
#pragma unroll
            for (int k = 0; k < 4; ++k) { const u32x4 zr = *(const u32x4*)(zp + k * 8);
                const unsigned zz[4] = {zr.x, zr.y, zr.z, zr.w};
#pragma unroll
                for (int e = 0; e < 4; ++e) { const float z0 = bflo(zz[e]), z1 = bfhi(zz[e]);
                    const float y0 = Y[tl * 65 + ph * 32 + k * 8 + 2 * e], y1 = Y[tl * 65 + ph * 32 + k * 8 + 2 * e + 1];
                    const float a0 = y0 * z0 * sigmoidf_(z0), a1 = y1 * z1 * sigmoidf_(z1);
                    v[k * 8 + 2 * e] = a0; v[k * 8 + 2 * e + 1] = a1; sq += a0 * a0 + a1 * a1; } }
            sq += __shfl_xor(sq, 1);
            if (ph == 0) ssq[F.wave * 32 + tl] = sq;
            __syncthreads();
            float tot = 0.f;
#pragma unroll
            for (int w = 0; w < 8; ++w) tot += ssq[w * 32 + tl];
            const float rs = frsq(tot * (1.0f / 512.0f) + EPS);
            const float* gp = ng + hh * 64 + ph * 32;
#pragma unroll
            for (int k2 = 0; k2 < 2; ++k2) { unsigned ow[4];
#pragma unroll
                for (int kk = 0; kk < 2; ++kk) { const int k = 2 * k2 + kk; const f32x4 g0 = *(const f32x4*)(gp + k * 8), g1 = *(const f32x4*)(gp + k * 8 + 4);
                    ow[2 * kk] = pk4_fp8(v[k * 8 + 0] * rs * g0.x, v[k * 8 + 1] * rs * g0.y, v[k * 8 + 2] * rs * g0.z, v[k * 8 + 3] * rs * g0.w);
                    ow[2 * kk + 1] = pk4_fp8(v[k * 8 + 4] * rs * g1.x, v[k * 8 + 5] * rs * g1.y, v[k * 8 + 6] * rs * g1.z, v[k * 8 + 7] * rs * g1.w); }
                u32x4 o; o.x = ow[0]; o.y = ow[1]; o.z = ow[2]; o.w = ow[3];
                if (!dry) *(u32x4*)(YC8 + (size_t)(b * SEQ + t) * 1024 + hh * 64 + ph * 32 + k2 * 16) = o; }
            __syncthreads();
        }
    }
}

template <int PASS>
__device__ __forceinline__ void phase_lru(const Frame& F, const Params& P, int layer, const bool dry) {
    unsigned char* ws = (unsigned char*)F.ws;
    const bf16* LX = (const bf16*)(ws + WS_LX); bf16* LG = (bf16*)(ws + WS_LG);
    float* AGG = (float*)(ws + WS_AGG); const float* CARRY = (const float*)(ws + WS_CARRY);
    const bf16* WRT = (const bf16*)(ws + WS_WRT); const bf16* WIT = (const bf16*)(ws + WS_WIT);
    const float* cw = P.in[12] + (size_t)layer * 4 * 1024; const float* cb = P.in[13] + (size_t)layer * 1024;
    const float* br = P.in[15] + (size_t)layer * 1024; const float* bi = P.in[17] + (size_t)layer * 1024; const float* lam = P.in[18] + (size_t)layer * 1024;
    const int* pos = (const int*)P.in[1];
    LAS unsigned char* xc = F.lds + F.wave * 18432;
    LAS unsigned char* lgt = xc + 9216;
    const int lane = F.lane, hi = lane >> 5, l31 = lane & 31;
    for (int u = F.vcu; u < NB * 128; u += F.G) {
        const int b = u >> 7, tc = u & 127, t0 = tc * 64;
        const u64 rmask = __ballot(pos[b * SEQ + t0 + lane] == 0);
        for (int hsel = 0; hsel < 2; ++hsel) {
            const int hd = F.wave * 2 + hsel;
            {
                const int cg = lane & 7, ch = hd * 64 + cg * 8;
                float wv[4][8], bv8[8];
                { const f32x4 b0 = *(const f32x4*)(cb + ch), b1 = *(const f32x4*)(cb + ch + 4);
                  bv8[0] = b0.x; bv8[1] = b0.y; bv8[2] = b0.z; bv8[3] = b0.w; bv8[4] = b1.x; bv8[5] = b1.y; bv8[6] = b1.z; bv8[7] = b1.w; }
#pragma unroll
                for (int k = 0; k < 4; ++k) { const f32x4 w0 = *(const f32x4*)(cw + k * 1024 + ch), w1 = *(const f32x4*)(cw + k * 1024 + ch + 4);
                    wv[k][0] = w0.x; wv[k][1] = w0.y; wv[k][2] = w0.z; wv[k][3] = w0.w; wv[k][4] = w1.x; wv[k][5] = w1.y; wv[k][6] = w1.z; wv[k][7] = w1.w; }
                const int tb = t0 + (lane >> 3) * 8;
                u32x4 xr[11], gr[8];
#pragma unroll
                for (int k = 0; k < 11; ++k) { const int ts = tb - 3 + k; const u32x4 v = *(const u32x4*)(LX + (size_t)(b * SEQ + (ts < 0 ? 0 : ts)) * 1024 + ch);
                    xr[k] = (ts >= 0) ? v : (u32x4){0u, 0u, 0u, 0u}; }
                if (PASS == 3) {
#pragma unroll
                    for (int it = 0; it < 8; ++it) gr[it] = *(const u32x4*)(LG + (size_t)(b * SEQ + tb + it) * 1024 + ch); }
#pragma unroll
                for (int it = 0; it < 8; ++it) {
                    const int tl = (lane >> 3) * 8 + it;
                    float o[8];
#pragma unroll
                    for (int e = 0; e < 8; ++e) o[e] = bv8[e];
#pragma unroll
                    for (int k = 0; k < 4; ++k) { const u32x4 x = xr[it + k];
                        o[0] += bflo(x.x) * wv[k][0]; o[1] += bfhi(x.x) * wv[k][1]; o[2] += bflo(x.y) * wv[k][2]; o[3] += bfhi(x.y) * wv[k][3];
                        o[4] += bflo(x.z) * wv[k][4]; o[5] += bfhi(x.z) * wv[k][5]; o[6] += bflo(x.w) * wv[k][6]; o[7] += bfhi(x.w) * wv[k][7]; }
                    u32x4 pw; pw.x = pk2(o[0], o[1]); pw.y = pk2(o[2], o[3]); pw.z = pk2(o[4], o[5]); pw.w = pk2(o[6], o[7]);
                    *(LAS u32x4*)(xc + tl * 144 + cg * 16) = pw;
                    if (PASS == 3) *(LAS u32x4*)(lgt + tl * 144 + cg * 16) = gr[it];
                }
            }
            LDS_FENCE();
            for (int jt = 0; jt < 2; ++jt) {
                f32x16 R[2] = {zero16(), zero16()}, I[2] = {zero16(), zero16()};
#pragma unroll
                for (int ks = 0; ks < 4; ++ks) {
                    const bf16x8 wr = ld8(WRT + (size_t)hd * 4096 + (jt * 32 + l31) * 64 + 16 * ks + 8 * hi);
                    const bf16x8 wi = ld8(WIT + (size_t)hd * 4096 + (jt * 32 + l31) * 64 + 16 * ks + 8 * hi);
#pragma unroll
                    for (int tt = 0; tt < 2; ++tt) { const bf16x8 af = lds8(xc + (tt * 32 + l31) * 144 + (16 * ks + 8 * hi) * 2);
                        R[tt] = MFMA32(af, wr, R[tt]); I[tt] = MFMA32(af, wi, I[tt]); }
                }
                const int j = jt * 32 + l31, ch = hd * 64 + j;
                const float brj = br[ch], bij = bi[ch], sp = softplusf_(-lam[ch]);
                float av[2][16], bv[2][16], Pm[8], Lm[8];
#pragma unroll
                for (int tt = 0; tt < 2; ++tt)
#pragma unroll
                    for (int q = 0; q < 4; ++q) {
                        float pp = 1.f, ll = 0.f;
#pragma unroll
                        for (int e = 0; e < 4; ++e) { const int i = 4 * q + e, tl = 32 * tt + 8 * q + 4 * hi + e, t = t0 + tl;
                            const float r = sigmoidf_(R[tt][i] + brj), ig = sigmoidf_(I[tt][i] + bij);
                            const float la = -8.0f * r * sp;
                            const bool rs = (rmask >> tl) & 1ull;
                            const float a = rs ? 0.f : __expf(la);
                            const float mult = rs ? 1.f : __builtin_amdgcn_sqrtf(fmaxf(0.f, __builtin_fmaf(-a, a, 1.f)));
                            const float xv = bf1(*(const LAS bf16*)(xc + tl * 144 + j * 2));
                            const float bb = mult * ig * xv;
                            av[tt][i] = a; bv[tt][i] = bb; pp *= a; ll = a * ll + bb; }
                        Pm[tt * 4 + q] = pp; Lm[tt * 4 + q] = ll;
                    }
                float Pp[8], Lp[8];
#pragma unroll
                for (int k = 0; k < 8; ++k) { Pp[k] = __shfl_xor(Pm[k], 32); Lp[k] = __shfl_xor(Lm[k], 32); }
                float cin[8];
                float c = (PASS == 3) ? CARRY[((size_t)b * 128 + tc) * 1024 + ch] : 0.f, ptot = 1.f;
#pragma unroll
                for (int k = 0; k < 16; ++k) { const int gq = k >> 1; const bool mine = ((k & 1) == hi);
                    const float pk = mine ? Pm[gq] : Pp[gq], lk = mine ? Lm[gq] : Lp[gq];
                    if (mine) cin[gq] = c;
                    c = pk * c + lk; ptot *= pk; }
                if (PASS == 1) {
                    if (hi == 0) { float* ap = AGG + (((size_t)b * 128 + tc) * 1024 + ch) * 2; ap[0] = ptot; ap[1] = c; }
                } else {
#pragma unroll
                    for (int tt = 0; tt < 2; ++tt)
#pragma unroll
                        for (int q = 0; q < 4; ++q) { float h = cin[tt * 4 + q];
#pragma unroll
                            for (int e = 0; e < 4; ++e) { const int i = 4 * q + e, tl = 32 * tt + 8 * q + 4 * hi + e;
                                h = av[tt][i] * h + bv[tt][i];
                                LAS bf16* gp = (LAS bf16*)(lgt + tl * 144 + j * 2);
                                *gp = f2bf(h * gelu_tanh(bf1(*gp))); } }
                }
            }
            LDS_FENCE();
            if (PASS == 3 && !dry) {
                const int cg = lane & 7, ch = hd * 64 + cg * 8;
#pragma unroll 4
                for (int it = 0; it < 8; ++it) { const int tl = it * 8 + (lane >> 3);
                    const u32x4 yv = *(const LAS u32x4*)(lgt + tl * 144 + cg * 16);
                    u32x2 o; o.x = pk4_fp8(bflo(yv.x), bfhi(yv.x), bflo(yv.y), bfhi(yv.y)); o.y = pk4_fp8(bflo(yv.z), bfhi(yv.z), bflo(yv.w), bfhi(yv.w));
                    *(u32x2*)(ws + WS_YB8 + (size_t)(b * SEQ + t0 + tl) * 1024 + ch) = o; }
            }
            LDS_FENCE();
        }
    }
}
__device__ __forceinline__ void phase_lru2(const Frame& F) {
    const float* AGG = (const float*)((unsigned char*)F.ws + WS_AGG); float* CARRY = (float*)((unsigned char*)F.ws + WS_CARRY);
    if (F.wave != 0) return;
    for (int u = F.vcu; u < 64; u += F.G) {
        const int b = u >> 4, ch = (u & 15) * 64 + F.lane;
        float h = 0.f;
        for (int c0 = 0; c0 < 128; c0 += 16) {
            float2 pl[16];
#pragma unroll
            for (int k = 0; k < 16; ++k) pl[k] = *(const float2*)(AGG + (((size_t)b * 128 + c0 + k) * 1024 + ch) * 2);
#pragma unroll
            for (int k = 0; k < 16; ++k) { CARRY[((size_t)b * 128 + c0 + k) * 1024 + ch] = h; h = pl[k].x * h + pl[k].y; }
        }
    }
}

#define DPPF(v, ctrl) __builtin_bit_cast(float, __builtin_amdgcn_update_dpp(0, __builtin_bit_cast(int, (v)), (ctrl), 0xf, 0xf, true))
constexpr float QSCALE = 0.125f * 1.4426950408889634f;
__device__ __forceinline__ void phase_n0(const Frame& F, const Params& P, int layer, const bool dry) {
    unsigned char* ws = (unsigned char*)F.ws;
    bf16* Q = (bf16*)(ws + WS_Q); const bf16* KV = (const bf16*)(ws + WS_KV);
    bf16* KC = (bf16*)(ws + WS_KC); bf16* KS = (bf16*)(ws + WS_KS); bf16* KW = (bf16*)(ws + WS_KW);
    bf16* VST = (bf16*)(ws + WS_VST); bf16* VWT = (bf16*)(ws + WS_VWT);
    const float* qg = P.in[4] + layer * 64; const float* kg = P.in[5] + layer * 64;
    const int* pos = (const int*)P.in[1];
    const int lane = F.lane;
    LAS bf16* tile = (LAS bf16*)F.lds;
    LAS float* sct = (LAS float*)(F.lds + 40960);
    const int p4 = lane & 3;
    float qg1[8], qg2[8], kg1[8], kg2[8];
#pragma unroll
    for (int e = 0; e < 8; ++e) { qg1[e] = qg[8 * p4 + e]; qg2[e] = qg[32 + 8 * p4 + e]; kg1[e] = kg[8 * p4 + e]; kg2[e] = kg[32 + 8 * p4 + e]; }
    for (int u = F.vcu; u < NB * 128; u += F.G) {
        const int b = u >> 7, tt = u & 127;
#pragma unroll
        for (int k = 0; k < 4; ++k) { const int e = F.tid + k * NTHREADS, tl = e >> 5, i = e & 31;
            const float inv = exp2f(-(float)i * (13.287712379549449f / 32.0f));
            const float ang = (float)pos[(size_t)b * SEQ + tt * 64 + tl] * inv;
            const double r = (double)ang - 6.283185307179586 * rint((double)ang * 0.15915494309189535);
            float sn, cs; __sincosf((float)r, &sn, &cs);
            sct[2 * e] = cs; sct[2 * e + 1] = sn; }
        __syncthreads();
#define N0_ROPE(xa, xc, g1, g2, osc, tl_, oa, oc) do { \
            float x1[8] = {bflo(xa.x), bfhi(xa.x), bflo(xa.y), bfhi(xa.y), bflo(xa.z), bfhi(xa.z), bflo(xa.w), bfhi(xa.w)}; \
            float x2[8] = {bflo(xc.x), bfhi(xc.x), bflo(xc.y), bfhi(xc.y), bflo(xc.z), bfhi(xc.z), bflo(xc.w), bfhi(xc.w)}; \
            float ss = 0.f; _Pragma("unroll") for (int e = 0; e < 8; ++e) ss += x1[e] * x1[e] + x2[e] * x2[e]; \
            ss += DPPF(ss, 0xB1); ss += DPPF(ss, 0x4E); \
            const float rs = frsq(ss * (1.0f / 64.0f) + EPS) ; \
            float o1[8], o2[8]; \
            _Pragma("unroll") for (int e2 = 0; e2 < 4; ++e2) { const f32x4 cq = *(const LAS f32x4*)(sct + ((tl_) * 32 + 8 * p4 + 2 * e2) * 2); \
                { const float y1 = x1[2 * e2] * rs * g1[2 * e2], y2 = x2[2 * e2] * rs * g2[2 * e2]; o1[2 * e2] = (y1 * cq.x - y2 * cq.y) * (osc); o2[2 * e2] = (y2 * cq.x + y1 * cq.y) * (osc); } \
                { const float y1 = x1[2 * e2 + 1] * rs * g1[2 * e2 + 1], y2 = x2[2 * e2 + 1] * rs * g2[2 * e2 + 1]; o1[2 * e2 + 1] = (y1 * cq.z - y2 * cq.w) * (osc); o2[2 * e2 + 1] = (y2 * cq.z + y1 * cq.w) * (osc); } } \
            oa.x = pk2(o1[0], o1[1]); oa.y = pk2(o1[2], o1[3]); oa.z = pk2(o1[4], o1[5]); oa.w = pk2(o1[6], o1[7]); \
            oc.x = pk2(o2[0], o2[1]); oc.y = pk2(o2[2], o2[3]); oc.z = pk2(o2[4], o2[5]); oc.w = pk2(o2[6], o2[7]); } while (0)
        { const int hd = lane >> 2;
#pragma unroll 1
          for (int k0 = 0; k0 < 8; k0 += 4) {
              u32x4 xa[4], xc[4];
#pragma unroll
              for (int k = 0; k < 4; ++k) { const bf16* src = Q + ((size_t)b * SEQ + tt * 64 + F.wave * 8 + k0 + k) * 1024 + hd * 64 + 8 * p4; xa[k] = *(const u32x4*)src; xc[k] = *(const u32x4*)(src + 32); }
#pragma unroll
              for (int k = 0; k < 4; ++k) { const int tl_ = F.wave * 8 + k0 + k; u32x4 oa, oc;
                  N0_ROPE(xa[k], xc[k], qg1, qg2, QSCALE, tl_, oa, oc);
                  bf16* dst = Q + ((size_t)b * SEQ + tt * 64 + tl_) * 1024 + hd * 64 + 8 * p4;
                  if (!dry) { *(u32x4*)dst = oa; *(u32x4*)(dst + 32) = oc; } } } }
        { const int tsub = lane >= 24 ? 1 : 0, r = lane - 24 * tsub, kk = (r >> 2) % 6, which = kk >> 1, gk = kk & 1; const bool act = lane < 48;
          u32x4 xa[4], xc[4];
#pragma unroll
          for (int it = 0; it < 4; ++it) { const bf16* src = KV + ((size_t)b * SEQ + tt * 64 + F.wave * 8 + 2 * it + tsub) * 768 + which * 256 + gk * 64 + 8 * p4; xa[it] = *(const u32x4*)src; xc[it] = *(const u32x4*)(src + 32); }
#pragma unroll
          for (int it = 0; it < 4; ++it) { const int tl_ = F.wave * 8 + 2 * it + tsub; u32x4 oa, oc;
              N0_ROPE(xa[it], xc[it], kg1, kg2, 1.0f, tl_, oa, oc);
              bf16* dst = (which == 0 ? KC : (which == 1 ? KS : KW)) + ((size_t)b * SEQ + tt * 64 + tl_) * 128 + gk * 64 + 8 * p4;
              if (act) { *(u32x4*)dst = oa; *(u32x4*)(dst + 32) = oc; } } }
#undef N0_ROPE
        { const int tl = F.tid >> 3, cg = F.tid & 7; const size_t m = (size_t)b * SEQ + tt * 64 + tl;
#pragma unroll
          for (int w2 = 0; w2 < 2; ++w2)
#pragma unroll
            for (int ps = 0; ps < 2; ++ps) { const int col = (cg + 8 * ps) * 8;
                const u32x4 v = *(const u32x4*)(KV + m * 768 + (w2 == 0 ? 384 : 640) + col);
                const unsigned vv[4] = {v.x, v.y, v.z, v.w};
#pragma unroll
                for (int e = 0; e < 4; ++e) { const int ps_ = (((tl >> 3) ^ cg) << 3) | (tl & 7); tile[(w2 * 128 + col + 2 * e) * 64 + ps_] = (bf16)(vv[e] & 0xffffu); tile[(w2 * 128 + col + 2 * e + 1) * 64 + ps_] = (bf16)(vv[e] >> 16); } }
          __syncthreads();
#pragma unroll
          for (int k = 0; k < 4; ++k) { const int idx = F.tid + k * NTHREADS, row = idx >> 3, chk = idx & 7;
              const u32x4 v = *(const LAS u32x4*)(tile + row * 64 + ((chk ^ ((row >> 3) & 7)) << 3));
              bf16* dst = (row < 128 ? VST : VWT) + ((size_t)b * 128 + (row & 127)) * SEQ + tt * 64 + chk * 8;
              *(u32x4*)dst = v; }
          __syncthreads(); }
    }
}

constexpr int N1_PE = 0, N1_H = 8192, N1_O = 8192 + 32 * 264 * 2;
__device__ __forceinline__ void phase_n1(const Frame& F, const Params& P, int layer) {
    unsigned char* ws = (unsigned char*)F.ws;
    const bf16* KC = (const bf16*)(ws + WS_KC); const bf16* KV = (const bf16*)(ws + WS_KV);
    bf16* KCMP = (bf16*)(ws + WS_KCMP); bf16* VCMPT = (bf16*)(ws + WS_VCMPT);
    const float* kg = P.in[5] + layer * 64;
    LAS float* pe = (LAS float*)(F.lds + N1_PE);
    LAS unsigned char* H = F.lds + N1_H;
    LAS float* O = (LAS float*)(F.lds + N1_O);
    const int lane = F.lane, hi = lane >> 5, l31 = lane & 31;
    for (int u = F.vcu; u < 256; u += F.G) {
        const int kind = u >> 7, b = (u >> 5) & 3, g = (u >> 4) & 1, ct = u & 15;
        const float* pes = (kind == 0 ? P.in[6] : P.in[7]) + (size_t)layer * 2048;
        for (int e = F.tid; e < 2048; e += NTHREADS) pe[e] = pes[e];
        __syncthreads();
        const bf16* W1T = (const bf16*)(ws + (kind == 0 ? WS_W1K : WS_W1V));
        const bf16* W2T = (const bf16*)(ws + (kind == 0 ? WS_W2K : WS_W2V));
        const int c = 32 * ct + l31; const bool valid = c < 511; const int cc = valid ? c : 510;
        const bf16* abase = (kind == 0) ? (KC + ((size_t)b * SEQ + 16 * cc) * 128 + g * 64) : (KV + ((size_t)b * SEQ + 16 * cc) * 768 + 128 + g * 64);
        const int apitch = (kind == 0) ? 128 : 768;
        f32x16 acc = zero16();
#pragma unroll 8
        for (int ks = 0; ks < 128; ++ks) {
            const int l = ks >> 2, d0 = (ks & 3) * 16 + 8 * hi;
            const u32x4 xr = *(const u32x4*)(abase + (size_t)l * apitch + d0);
            const f32x4 p0 = *(const LAS f32x4*)(pe + l * 64 + d0), p1 = *(const LAS f32x4*)(pe + l * 64 + d0 + 4);
            u32x4 o; o.x = pk2(bflo(xr.x) + p0.x, bfhi(xr.x) + p0.y); o.y = pk2(bflo(xr.y) + p0.z, bfhi(xr.y) + p0.w);
            o.z = pk2(bflo(xr.z) + p1.x, bfhi(xr.z) + p1.y); o.w = pk2(bflo(xr.w) + p1.z, bfhi(xr.w) + p1.w);
            if (!valid) { o.x = 0u; o.y = 0u; o.z = 0u; o.w = 0u; }
            const bf16x8 bfr = ld8(W1T + (size_t)(F.wave * 32 + l31) * 2048 + 16 * ks + 8 * hi);
            acc = MFMA32(__builtin_bit_cast(bf16x8, o), bfr, acc);
        }
#pragma unroll
        for (int i = 0; i < 16; ++i) *(LAS bf16*)(H + crow(i, hi) * 528 + (F.wave * 32 + l31) * 2) = f2bf(gelu_tanh(acc[i]));
        __syncthreads();
        if (F.wave < 2) {
            f32x16 a2 = zero16();
#pragma unroll 4
            for (int ks = 0; ks < 16; ++ks) {
                const bf16x8 af = lds8(H + l31 * 528 + (16 * ks + 8 * hi) * 2);
                const bf16x8 bfr = ld8(W2T + (size_t)(F.wave * 32 + l31) * 256 + 16 * ks + 8 * hi);
                a2 = MFMA32(af, bfr, a2);
            }
#pragma unroll
            for (int i = 0; i < 16; ++i) O[crow(i, hi) * 65 + F.wave * 32 + l31] = a2[i];
        }
        __syncthreads();
#pragma unroll
        for (int rr = 0; rr < 4; ++rr) {
            const int r = F.wave * 4 + rr, cr = 32 * ct + r;
            float v = O[r * 65 + lane];
            if (kind == 0) { const float ss = wave_sum(v * v); v = v * frsq(ss * (1.0f / 64.0f) + EPS) * kg[lane];
                if (cr >= 511) v = 0.f;
                KCMP[((size_t)(b * 2 + g) * 512 + cr) * 64 + lane] = f2bf(v); }
            else { if (cr >= 511) v = 0.f; VCMPT[((size_t)(b * 2 + g) * 64 + lane) * 512 + cr] = f2bf(v); }
        }
        __syncthreads();
    }
}

constexpr int A_STG = 65536, A_IMP = 2 * A_STG, A_SELM = A_IMP + 8 * 4 * 132 * 4, A_UNI = A_SELM + 512, A_RDY = A_UNI + 16, A_DNE = A_RDY + 32, A_END = A_DNE + 256;
static_assert(A_END <= MISC_OFF, "N2 LDS map");
__device__ __forceinline__ void stage_issue(LAS unsigned char* lds, int buf, int wave, int lane, const bf16* kb, int kp, const bf16* vb, int vp) {
    asm volatile("" : "+v"(lane)); lane &= 63;
    const bf16* base = (wave & 1) ? vb : kb; const int pitch = (wave & 1) ? vp : kp;
    LAS unsigned char* dst = lds + buf * A_STG + (wave >> 1) * 16384 + (wave & 1) * 8192;
    const int r8 = lane >> 3, cb = (lane & 7) ^ (r8 >> 1);
    const bf16* p0 = base + (size_t)r8 * pitch + cb * 8; const bf16* p1 = base + (size_t)r8 * pitch + (cb ^ 4) * 8;
    const size_t step = (size_t)8 * pitch;
#pragma unroll
    for (int q = 0; q < 8; ++q) {
        __builtin_amdgcn_global_load_lds((const unsigned*)((q & 1) ? p1 : p0), (LAS unsigned*)(dst + q * 1024), 16, 0, 0);
        p0 += step; p1 += step; asm volatile("" : "+v"(p0), "+v"(p1)); }
}
#define DMA_WAIT() asm volatile("s_waitcnt vmcnt(0)" ::: "memory")
__device__ __forceinline__ void half_issue(LAS unsigned char* dst, int lane, const bf16* base, int pitch) {
    asm volatile("" : "+v"(lane)); lane &= 63;
    const int r8 = lane >> 3, cb = (lane & 7) ^ (r8 >> 1);
    const bf16* p0 = base + (size_t)r8 * pitch + cb * 8; const bf16* p1 = base + (size_t)r8 * pitch + (cb ^ 4) * 8;
    const size_t step = (size_t)8 * pitch;
#pragma unroll
    for (int q = 0; q < 8; ++q) {
        __builtin_amdgcn_global_load_lds((const unsigned*)((q & 1) ? p1 : p0), (LAS unsigned*)(dst + q * 1024), 16, 0, 0);
        p0 += step; p1 += step; asm volatile("" : "+v"(p0), "+v"(p1)); }
}
__device__ __forceinline__ unsigned flag_ld(const LAS unsigned* p) { asm volatile("" ::: "memory"); const unsigned v = *(const volatile LAS unsigned*)p; asm volatile("" ::: "memory"); return (unsigned)__builtin_amdgcn_readfirstlane((int)v); }
__device__ __forceinline__ void flag_st(LAS unsigned* p, unsigned v) { asm volatile("" ::: "memory"); *(volatile LAS unsigned*)p = v; asm volatile("" ::: "memory"); }
typedef float f32x4v __attribute__((ext_vector_type(4)));
#define MFMA16(a, b, c) __builtin_amdgcn_mfma_f32_16x16x32_bf16((a), (b), (c), 0, 0, 0)
template <int MODE, bool MASKED, int gm>
__device__ __forceinline__ void attn_tile(const unsigned akoff, const unsigned bvoff, const LAS unsigned char* Kb, const LAS unsigned char* Vb, const bf16x8 (&qf)[2][2], f32x4v (&oacc)[2][4], float (&lsum)[2], int lane,
                                           const int (&tq)[2], int kbase, const float (&off)[2], LAS float* impw) {
    asm volatile("" : "+v"(lane)); lane &= 63;
    const int kg = lane >> 4, r15 = lane & 15;
    const unsigned AK = (unsigned)(size_t)Kb + akoff, BV = (unsigned)(size_t)Vb + bvoff;
    f32x4v s[2][4];
#pragma unroll
    for (int g = 0; g < 2; ++g)
#pragma unroll
        for (int kt = 0; kt < 4; ++kt) { s[g][kt][0] = -off[g]; s[g][kt][1] = -off[g]; s[g][kt][2] = -off[g]; s[g][kt][3] = -off[g]; }
#pragma unroll
    for (int kt = 0; kt < 4; ++kt)
#pragma unroll
        for (int ks = 0; ks < 2; ++ks) { const bf16x8 kf = lds8((const LAS unsigned char*)(AK ^ (unsigned)(ks << 6)) + kt * 2048);
            if (gm & 1) s[0][kt] = MFMA16(kf, qf[0][ks], s[0][kt]);
            if (gm & 2) s[1][kt] = MFMA16(kf, qf[1][ks], s[1][kt]); }
    bf16x8 pf[2][2];
#pragma unroll
    for (int g = 0; g < 2; ++g) {
        if (!((gm >> g) & 1)) continue;
#pragma unroll
        for (int kt = 0; kt < 4; ++kt) {
            const int lim = tq[g] - kbase - 16 * kt - 4 * kg;
#pragma unroll
            for (int i = 0; i < 4; ++i) {
                float e = __builtin_amdgcn_exp2f(s[g][kt][i]);
                if (MASKED) { bool valid;
                    if (MODE <= 1) valid = (16 * i + 31 <= tq[g] - 16 * (kbase + 16 * kt + 4 * kg)); else if (MODE == 2) valid = (i <= lim); else valid = (i <= lim) && (i + 512 > lim);
                    e = valid ? e : 0.f; }
                s[g][kt][i] = e; lsum[g] += e;
            }
            if (MODE == 1) {
                float a = s[g][kt][0] + s[g][kt][1] + s[g][kt][2] + 0.5f * s[g][kt][3], bq = 0.5f * s[g][kt][3];
                a += DPPF(a, 0xB1); bq += DPPF(bq, 0xB1); a += DPPF(a, 0x4E); bq += DPPF(bq, 0x4E); a += DPPF(a, 0x141); bq += DPPF(bq, 0x141);
                if ((lane & 7) == 0) { const int j = (kbase >> 2) + 4 * kt + kg; LAS float* ip = impw + (2 * g + (r15 >> 3)) * 132 + j;
                    atomicAdd((float*)ip, a); atomicAdd((float*)(ip + 1), bq); }
            }
        }
        if (MODE != 0) {
#pragma unroll
            for (int kp = 0; kp < 2; ++kp) { u32x4 pw; pw.x = pk2(s[g][2 * kp][0], s[g][2 * kp][1]); pw.y = pk2(s[g][2 * kp][2], s[g][2 * kp][3]);
                pw.z = pk2(s[g][2 * kp + 1][0], s[g][2 * kp + 1][1]); pw.w = pk2(s[g][2 * kp + 1][2], s[g][2 * kp + 1][3]); pf[g][kp] = __builtin_bit_cast(bf16x8, pw); }
        }
    }
    if (MODE == 0) return;
#pragma unroll
    for (int dt = 0; dt < 4; ++dt)
#pragma unroll
        for (int kp = 0; kp < 2; ++kp) {
            const LAS unsigned char* vp0 = (const LAS unsigned char*)(BV ^ (unsigned)((4 * kp) << 4)) + dt * 2048;
            const LAS unsigned char* vp1 = (const LAS unsigned char*)(BV ^ (unsigned)((4 * kp + 2) << 4)) + dt * 2048;
            const u32x2 v0 = *(const LAS u32x2*)vp0, v1 = *(const LAS u32x2*)vp1;
            u32x4 va; va.x = v0.x; va.y = v0.y; va.z = v1.x; va.w = v1.y; const bf16x8 vf = __builtin_bit_cast(bf16x8, va);
            if (gm & 1) oacc[0][dt] = MFMA16(vf, pf[0][kp], oacc[0][dt]);
            if (gm & 2) oacc[1][dt] = MFMA16(vf, pf[1][kp], oacc[1][dt]);
        }
}
template <int MODE, int GM>
__device__ __forceinline__ void attn_tile_m(bool masked, const unsigned akoff, const unsigned bvoff, const LAS unsigned char* Kb, const LAS unsigned char* Vb, const bf16x8 (&qf)[2][2], f32x4v (&oacc)[2][4], float (&lsum)[2], int lane,
                                             const int (&tq)[2], int kbase, const float (&off)[2], LAS float* impw) {
    if (masked) attn_tile<MODE, true, GM>(akoff, bvoff, Kb, Vb, qf, oacc, lsum, lane, tq, kbase, off, impw); else attn_tile<MODE, false, GM>(akoff, bvoff, Kb, Vb, qf, oacc, lsum, lane, tq, kbase, off, impw);
}
#define OACC_ZERO(o) do { _Pragma("unroll") for (int g_ = 0; g_ < 2; ++g_) _Pragma("unroll") for (int d_ = 0; d_ < 4; ++d_) { o[g_][d_][0] = 0.f; o[g_][d_][1] = 0.f; o[g_][d_][2] = 0.f; o[g_][d_][3] = 0.f; } } while (0)

__device__ __forceinline__ void phase_n2(const Frame& F, const Params& P, int layer, const bool dry) {
    unsigned char* ws = (unsigned char*)F.ws;
    bf16* Q = (bf16*)(ws + WS_Q); const bf16* MISC = (const bf16*)(ws + WS_MISC);
    const bf16* KS = (const bf16*)(ws + WS_KS); const bf16* KW = (const bf16*)(ws + WS_KW);
    const bf16* VST = (const bf16*)(ws + WS_VST); const bf16* VWT = (const bf16*)(ws + WS_VWT);
    const bf16* KCMP = (const bf16*)(ws + WS_KCMP); const bf16* VCMPT = (const bf16*)(ws + WS_VCMPT);
    const float* qg = P.in[4] + layer * 64; const float* kg_ = P.in[5] + layer * 64;
    LAS unsigned char* lds = F.lds;
    const int lane = F.lane, tid = F.tid, wave = F.wave, kg = lane >> 4, r15 = lane & 15, qq = r15 >> 3, h = r15 & 7;
    float gqm, gkm;
    { float a = fabsf(qg[lane]), c = fabsf(kg_[lane]);
#pragma unroll
      for (int o = 1; o < 64; o <<= 1) { a = fmaxf(a, __shfl_xor(a, o)); c = fmaxf(c, __shfl_xor(c, o)); }
      gqm = a; gkm = c; }
    const float Mb2 = 8.0f * gqm * gkm * 1.4426950408889634f;
    LAS float* impw = (LAS float*)(lds + A_IMP) + wave * 4 * 132;
    LAS u64* selm = (LAS u64*)(lds + A_SELM); LAS u64* uni = (LAS u64*)(lds + A_UNI);
    const int wt = wave >> 1;
    const int ngrp = (F.G % 8 == 0) ? 8 : 1, per = F.G / ngrp, grp = F.vcu / per;
    for (int u = F.vcu % per; u < (8 / ngrp) * 256; u += per) {
        const int rnd = (u & 255) / per, pos_ = (u & 255) % per, qt = (256 % per == 0) ? 255 - (rnd * per + ((rnd & 1) ? (per - 1 - pos_) : pos_)) : 255 - (u & 255);
        const int bg = ngrp == 8 ? grp : (u >> 8), b = bg >> 1, g = bg & 1;
        const int t0 = 32 * qt;
        unsigned akoff, bvoff; { int l_ = lane; asm volatile("" : "+v"(l_)); l_ &= 63; const int kg_l = l_ >> 4, r_l = l_ & 15, sw_l = (r_l >> 1) & 7;
            akoff = (unsigned)(r_l * 128 + (((kg_l ^ sw_l) & 3) << 4) + ((sw_l & 4) << 4)); bvoff = (unsigned)(r_l * 128 + 8 * (kg_l & 1) + (((kg_l >> 1) ^ sw_l) << 4)); }
        const int tq[2] = {t0 + 4 * wave + qq, t0 + 4 * wave + 2 + qq};
        bf16x8 qf[2][2]; float gate[2][3];
#pragma unroll
        for (int gi = 0; gi < 2; ++gi) { const size_t mq = (size_t)b * SEQ + tq[gi];
#pragma unroll
            for (int ks = 0; ks < 2; ++ks) qf[gi][ks] = ld8(Q + mq * 1024 + (g * 8 + h) * 64 + 32 * ks + 8 * kg);
#pragma unroll
            for (int k = 0; k < 3; ++k) gate[gi][k] = sigmoidf_(bf1(MISC[mq * 256 + 16 + (g * 8 + h) * 3 + k])); }
        for (int e = lane; e < 4 * 132; e += 64) impw[e] = 0.f;
        if (tid < 2) uni[tid] = 0ull;
        if (tid < 72) ((LAS unsigned*)(lds + A_RDY))[tid] = 0u;
        f32x4v otot[2][4]; OACC_ZERO(otot);
        const float offb[2] = {Mb2, Mb2};
        const int ncmp = min((t0 >> 4) + 1, 511), nct = (ncmp + 63) >> 6;
        const bf16* kcb = KCMP + (size_t)(b * 2 + g) * 512 * 64; const bf16* vcb = VCMPT + (size_t)(b * 2 + g) * 64 * 512;
        __syncthreads();
        if (wt < nct) stage_issue(lds, 0, wave, lane, kcb + (size_t)wt * 64 * 64, 64, vcb + wt * 64, 512);
        if (wt + 4 < nct) stage_issue(lds, 1, wave, lane, kcb + (size_t)(wt + 4) * 64 * 64, 64, vcb + (wt + 4) * 64, 512);
        DMA_WAIT(); __syncthreads();
        {
            float l1[2] = {0.f, 0.f}; f32x4v oacc[2][4]; OACC_ZERO(oacc);
            for (int kt = 0; kt < nct; ++kt) { const LAS unsigned char* tb = lds + (kt >> 2) * A_STG + (kt & 3) * 16384;
                attn_tile_m<0, 3>(1024 * kt + 1039 > t0, akoff, bvoff, tb, tb + 8192, qf, oacc, l1, lane, tq, 64 * kt, offb, impw); }
            float off2[2];
#pragma unroll
            for (int gi = 0; gi < 2; ++gi) { float l = l1[gi]; l += __shfl_xor(l, 16); l += __shfl_xor(l, 32); off2[gi] = l > 0.f ? Mb2 + __log2f(l) : 1e30f; }
            float l2[2] = {0.f, 0.f};
            for (int kt = 0; kt < nct; ++kt) { const LAS unsigned char* tb = lds + (kt >> 2) * A_STG + (kt & 3) * 16384;
                attn_tile_m<1, 3>(1024 * kt + 1039 > t0, akoff, bvoff, tb, tb + 8192, qf, oacc, l2, lane, tq, 64 * kt, off2, impw); }
#pragma unroll
            for (int gi = 0; gi < 2; ++gi)
#pragma unroll
                for (int dt = 0; dt < 4; ++dt) otot[gi][dt] = oacc[gi][dt] * gate[gi][0];
        }
        LDS_FENCE();
        u64 wu0 = 0ull, wu1 = 0ull, gu0[2] = {0ull, 0ull}, gu1[2] = {0ull, 0ull};
        for (int q4 = 0; q4 < 4; ++q4) {
            const int tqq = t0 + 4 * wave + q4, cur = tqq >> 6;
            unsigned key[2];
#pragma unroll
            for (int k2 = 0; k2 < 2; ++k2) { const int j = lane + 64 * k2;
                const bool forced = (j == 0) || (j == cur) || (j == cur - 1);
                const unsigned ib = __builtin_bit_cast(unsigned, impw[q4 * 132 + j]);
                key[k2] = forced ? (0xFFFFFF80u | (unsigned)(127 - j)) : ((j <= cur) ? ((((ib >> 7) + 1u) << 7) | (unsigned)(127 - j)) : (unsigned)(127 - j)); }
            unsigned thr = 0u;
            for (int bit = 31; bit >= 0; --bit) {
                const unsigned cand = thr | (1u << bit);
                const int cnt = __popcll(__ballot(key[0] >= cand)) + __popcll(__ballot(key[1] >= cand));
                if (cnt >= 16) thr = cand;
            }
            const u64 m0 = __ballot(key[0] >= thr), m1 = __ballot(key[1] >= thr);
            wu0 |= m0; wu1 |= m1; gu0[q4 >> 1] |= m0; gu1[q4 >> 1] |= m1;
            if (lane == 0) { selm[(wave * 4 + q4) * 2] = m0; selm[(wave * 4 + q4) * 2 + 1] = m1; }
        }
        if (lane == 0) { atomicOr((u64*)&uni[0], wu0); atomicOr((u64*)&uni[1], wu1); }
        __syncthreads();
        u64 mq0[2], mq1[2];
#pragma unroll
        for (int gi = 0; gi < 2; ++gi) { mq0[gi] = selm[(wave * 4 + 2 * gi + qq) * 2]; mq1[gi] = selm[(wave * 4 + 2 * gi + qq) * 2 + 1]; }
        const int curb = t0 >> 6;
        u64 ul0 = uni[0], ul1 = uni[1];
        if (curb < 63) { ul0 &= ((2ull << curb) - 1ull); ul1 = 0ull; } else if (curb == 63) { ul1 = 0ull; } else { ul1 &= ((2ull << (curb - 64)) - 1ull); }
        {
            float ls[2] = {0.f, 0.f}; f32x4v oacc[2][4]; OACC_ZERO(oacc);
            const bf16* ksb = KS + (size_t)b * SEQ * 128 + g * 64; const bf16* vsb = VST + ((size_t)b * 128 + g * 64) * SEQ;
            LAS unsigned* rdy = (LAS unsigned*)(lds + A_RDY); LAS unsigned* dne = (LAS unsigned*)(lds + A_DNE);
            u64 c0 = ul0, c1 = ul1, a0 = ul0, a1 = ul1;
#define NEXT1(r0, r1, j_) do { j_ = -1; if (r0) { j_ = __builtin_ctzll(r0); r0 &= r0 - 1ull; } else if (r1) { j_ = 64 + __builtin_ctzll(r1); r1 &= r1 - 1ull; } } while (0)
#pragma unroll 1
            for (int p = 0; p < 4; ++p) { int j; NEXT1(a0, a1, j);
                if (j >= 0 && wave == p) { LAS unsigned char* sb = lds + p * 16384;
                    half_issue(sb, lane, ksb + (size_t)j * 64 * 128, 128); half_issue(sb + 8192, lane, vsb + j * 64, SEQ);
                    DMA_WAIT(); flag_st(rdy + p, 1u); } }
            int i = 0;
#pragma unroll 1
            for (;;) {
                int j; NEXT1(c0, c1, j); if (j < 0) break;
                int ja; NEXT1(a0, a1, ja);
                const int sa = (i + 4) & 7, ga = (i + 4) >> 3;
                bool pend = false;
                if (ja >= 0 && sa == wave) {
                    for (;;) { const unsigned v = *(const volatile LAS unsigned*)(dne + sa * 8 + (lane & 7)); if (__ballot(v >= (unsigned)ga) == ~0ull) break; __builtin_amdgcn_s_sleep(1); }
                    asm volatile("" ::: "memory");
                    LAS unsigned char* sb = lds + sa * 16384;
                    half_issue(sb, lane, ksb + (size_t)ja * 64 * 128, 128); half_issue(sb + 8192, lane, vsb + ja * 64, SEQ);
                    pend = true;
                }
                const int jj = j & 63, sl = i & 7;
                const int gm = (int)(((j < 64 ? gu0[0] : gu1[0]) >> jj) & 1ull) | ((int)(((j < 64 ? gu0[1] : gu1[1]) >> jj) & 1ull) << 1);
                if (gm) { float offs[2];
#pragma unroll
                    for (int gi = 0; gi < 2; ++gi) offs[gi] = (((j < 64 ? mq0[gi] : mq1[gi]) >> jj) & 1ull) ? Mb2 : 1e30f;
                    while (flag_ld(rdy + sl) < (unsigned)((i >> 3) + 1)) __builtin_amdgcn_s_sleep(1);
                    const LAS unsigned char* tb = lds + sl * 16384;
                    if (gm == 1) attn_tile_m<2, 1>(j == curb, akoff, bvoff, tb, tb + 8192, qf, oacc, ls, lane, tq, 64 * j, offs, impw);
                    else if (gm == 2) attn_tile_m<2, 2>(j == curb, akoff, bvoff, tb, tb + 8192, qf, oacc, ls, lane, tq, 64 * j, offs, impw);
                    else attn_tile_m<2, 3>(j == curb, akoff, bvoff, tb, tb + 8192, qf, oacc, ls, lane, tq, 64 * j, offs, impw); }
                if (pend) { DMA_WAIT(); flag_st(rdy + sa, (unsigned)(ga + 1)); }
                asm volatile("s_waitcnt lgkmcnt(0)" ::: "memory");
                flag_st(dne + sl * 8 + wave, (unsigned)((i >> 3) + 1));
                ++i;
            }
#undef NEXT1
            __syncthreads();
#pragma unroll
            for (int gi = 0; gi < 2; ++gi) { float l = ls[gi]; l += __shfl_xor(l, 16); l += __shfl_xor(l, 32); const float sc = l > 0.f ? gate[gi][1] * frcp(l) : 0.f;
#pragma unroll
                for (int dt = 0; dt < 4; ++dt) otot[gi][dt] += oacc[gi][dt] * sc; }
        }
        {
            float ls[2] = {0.f, 0.f}; f32x4v oacc[2][4]; OACC_ZERO(oacc);
            const bf16* kwb = KW + (size_t)b * SEQ * 128 + g * 64; const bf16* vwb = VWT + ((size_t)b * 128 + g * 64) * SEQ;
            const int kt0 = max(0, t0 - 511) >> 6, kt1 = t0 >> 6;
            if (kt0 + wt <= kt1) stage_issue(lds, 0, wave, lane, kwb + (size_t)(kt0 + wt) * 64 * 128, 128, vwb + (kt0 + wt) * 64, SEQ);
            DMA_WAIT(); __syncthreads();
            int bi = 0;
            for (int ks0 = kt0; ks0 <= kt1; ks0 += 4) {
                if (ks0 + 4 + wt <= kt1) stage_issue(lds, bi ^ 1, wave, lane, kwb + (size_t)(ks0 + 4 + wt) * 64 * 128, 128, vwb + (ks0 + 4 + wt) * 64, SEQ);
#pragma unroll
                for (int q = 0; q < 4; ++q) { const int kt = ks0 + q;
                    if (kt <= kt1) { const bool full = (64 * kt >= t0 + 31 - 511) && (64 * kt + 63 <= t0);
                        const LAS unsigned char* tb = lds + bi * A_STG + q * 16384;
                        attn_tile_m<3, 3>(!full, akoff, bvoff, tb, tb + 8192, qf, oacc, ls, lane, tq, 64 * kt, offb, impw); } }
                DMA_WAIT(); __syncthreads();
                bi ^= 1;
            }
#pragma unroll
            for (int gi = 0; gi < 2; ++gi) { float l = ls[gi]; l += __shfl_xor(l, 16); l += __shfl_xor(l, 32); const float sc = l > 0.f ? gate[gi][2] * frcp(l) : 0.f;
#pragma unroll
                for (int dt = 0; dt < 4; ++dt) otot[gi][dt] += oacc[gi][dt] * sc; }
        }
#pragma unroll
        for (int gi = 0; gi < 2; ++gi) { unsigned char* op = ws + WS_YA8 + ((size_t)b * SEQ + tq[gi]) * 1024 + (g * 8 + h) * 64 + 4 * kg;
#pragma unroll
            for (int dt = 0; dt < 4; ++dt) { const unsigned w = pk4_fp8(otot[gi][dt][0], otot[gi][dt][1], otot[gi][dt][2], otot[gi][dt][3]);
                if (!dry) *(unsigned*)(op + 16 * dt) = w; } }
    }
}

__device__ __forceinline__ float wave_max(float v) {
#pragma unroll
    for (int o = 1; o < 64; o <<= 1) v = fmaxf(v, __shfl_xor(v, o));
    return v;
}
__device__ __forceinline__ void quant_vals(const f32x4 (&v)[4], unsigned (&q)[4], float& scale) {
    float am = 0.f;
#pragma unroll
    for (int j = 0; j < 4; ++j) am = fmaxf(am, fmaxf(fmaxf(fabsf(v[j].x), fabsf(v[j].y)), fmaxf(fabsf(v[j].z), fabsf(v[j].w))));
    am = wave_max(am);
    const float inv = am > 0.f ? 448.0f * frcp(am) : 0.f; scale = am > 0.f ? am * (1.0f / 448.0f) : 0.f;
#pragma unroll
    for (int j = 0; j < 4; ++j) { int w = 0; w = __builtin_amdgcn_cvt_pk_fp8_f32(fminf(fmaxf(v[j].x * inv, -448.f), 448.f), fminf(fmaxf(v[j].y * inv, -448.f), 448.f), w, false);
        w = __builtin_amdgcn_cvt_pk_fp8_f32(fminf(fmaxf(v[j].z * inv, -448.f), 448.f), fminf(fmaxf(v[j].w * inv, -448.f), 448.f), w, true); q[j] = (unsigned)w; }
}
__device__ __forceinline__ void phase_r0(const Frame& F, const Params& P, int layer) {
    unsigned char* ws = (unsigned char*)F.ws;
    rms_rows(F, P.out, P.in[27] + (size_t)layer * DM, (bf16*)(ws + WS_HN));
    const float* us = P.in[30] + (size_t)layer * 16384 * 1024; const float* vs = P.in[31] + (size_t)layer * 16384 * 1024;
    unsigned* U8 = (unsigned*)(ws + WS_U8); unsigned* V8 = (unsigned*)(ws + WS_V8); float* SU = (float*)(ws + WS_SU); float* SV = (float*)(ws + WS_SV);
    const int lane = F.lane;
    for (int e = F.gw; e < 16384; e += F.NGW) {
        f32x4 uv[4], vv[4];
#pragma unroll
        for (int j = 0; j < 4; ++j) { uv[j] = ((const f32x4*)(us + (size_t)e * 1024) + lane)[64 * j]; vv[j] = ((const f32x4*)(vs + (size_t)e * 1024) + lane)[64 * j]; }
        unsigned q[4]; float sc;
        quant_vals(uv, q, sc);
#pragma unroll
        for (int j = 0; j < 4; ++j) U8[((size_t)(2 * j + (lane >> 5)) * 16384 + e) * 32 + (lane & 31)] = q[j];
        if (lane == 0) SU[e] = sc;
        quant_vals(vv, q, sc);
#pragma unroll
        for (int j = 0; j < 4; ++j) V8[((size_t)(2 * j + (lane >> 5)) * 16384 + e) * 32 + (lane & 31)] = q[j];
        if (lane == 0) SV[e] = sc;
    }
}

#define CE_DESC(a, b) do { const unsigned _mx = (a) > (b) ? (a) : (b), _mn = (a) > (b) ? (b) : (a); (a) = _mx; (b) = _mn; } while (0)
__device__ __forceinline__ void sort16_desc(unsigned (&v)[64], const int base) {
#pragma unroll
    for (int k = 2; k <= 16; k <<= 1)
#pragma unroll
        for (int j = k >> 1; j > 0; j >>= 1)
#pragma unroll
            for (int i = 0; i < 16; ++i) { const int l = i ^ j;
                if (l > i) { if ((i & k) == 0) CE_DESC(v[base + i], v[base + l]); else CE_DESC(v[base + l], v[base + i]); } }
}
__device__ __forceinline__ void merge16_top(unsigned (&v)[64], const int abase, const int bbase) {
#pragma unroll
    for (int i = 0; i < 16; ++i) { const unsigned x = v[abase + i], y = v[bbase + 15 - i]; v[abase + i] = x > y ? x : y; }
#pragma unroll
    for (int j = 8; j > 0; j >>= 1)
#pragma unroll
        for (int i = 0; i < 16; ++i) { const int l = i ^ j; if (l > i) CE_DESC(v[abase + i], v[abase + l]); }
}
__device__ __forceinline__ void top16_of_64(unsigned (&v)[64]) {
    sort16_desc(v, 0); sort16_desc(v, 16); sort16_desc(v, 32); sort16_desc(v, 48);
    merge16_top(v, 0, 16); merge16_top(v, 32, 48); merge16_top(v, 0, 32);
}
__device__ __forceinline__ unsigned f2sortable(float f) { const unsigned u = __builtin_bit_cast(unsigned, f); return (u & 0x80000000u) ? ~u : (u | 0x80000000u); }
__device__ __forceinline__ float sortable2f(unsigned s) { const unsigned u = (s & 0x80000000u) ? (s & 0x7fffffffu) : ~s; return __builtin_bit_cast(float, u); }

constexpr int R2_SK = 0, R2_IDX = 69632;
__device__ __forceinline__ void phase_r2(const Frame& F) {
    unsigned char* ws = (unsigned char*)F.ws;
    const bf16* PQ = (const bf16*)(ws + WS_PQ); const bf16* SK = (const bf16*)(ws + WS_SK);
    int* RIDX = (int*)(ws + WS_RIDX); float* RG = (float*)(ws + WS_RG);
    LAS unsigned char* sk = F.lds + R2_SK;
    LAS unsigned char* idxs = F.lds + R2_IDX + (F.wave * 64 + F.lane) * 32;
    const int lane = F.lane, hi = lane >> 5, l31 = lane & 31;
    const bool keep = (F.G % 8 == 0);
    int h_loaded = -1;
    for (int u = keep ? (F.vcu >> 3) : F.vcu; u < (keep ? 128 : 128 * 8); u += keep ? (F.G >> 3) : F.G) {
        const int h = keep ? (F.vcu & 7) : (u & 7), tt = keep ? u : (u >> 3);
        if (h != h_loaded) {
            __syncthreads();
#pragma unroll
            for (int k = 0; k < 8; ++k) { const int idx = F.tid + k * NTHREADS, row = idx >> 4, ch = idx & 15;
                *(LAS u32x4*)(sk + row * 272 + ch * 16) = *(const u32x4*)(SK + ((size_t)h * 256 + row) * 128 + ch * 8); }
            __syncthreads();
            h_loaded = h;
        }
        const int tok = tt * 256 + F.wave * 32 + l31;
        unsigned top[2][16];
#pragma unroll
        for (int x = 0; x < 2; ++x) {
            f32x16 acc[4] = {zero16(), zero16(), zero16(), zero16()};
#pragma unroll
            for (int ks = 0; ks < 8; ++ks) {
                const bf16x8 qfr = ld8(PQ + (size_t)tok * 2048 + h * 256 + x * 128 + 16 * ks + 8 * hi);
#pragma unroll
                for (int kt = 0; kt < 4; ++kt) { const bf16x8 kf = lds8(sk + (x * 128 + kt * 32 + l31) * 272 + (16 * ks + 8 * hi) * 2); acc[kt] = MFMA32(kf, qfr, acc[kt]); }
            }
            unsigned v[64];
#pragma unroll
            for (int kt = 0; kt < 4; ++kt)
#pragma unroll
                for (int i = 0; i < 16; ++i) { const int key = kt * 32 + crow(i, hi); v[kt * 16 + i] = (f2sortable(acc[kt][i]) & ~0x7Fu) | (unsigned)(127 - key); }
            top16_of_64(v);
#pragma unroll
            for (int i = 0; i < 16; ++i) top[x][i] = v[i];
        }
        unsigned mine[64];
#pragma unroll
        for (int i = 0; i < 16; ++i) {
            const unsigned send = hi ? top[0][i] : top[1][i];
            const unsigned got = __shfl_xor(send, 32);
            mine[i] = hi ? top[1][i] : top[0][i]; mine[16 + i] = got;
        }
        merge16_top(mine, 0, 16);
        unsigned L0[16], L1[16];
#pragma unroll
        for (int i = 0; i < 16; ++i) { const unsigned got = __shfl_xor(mine[i], 32); L0[i] = hi ? got : mine[i]; L1[i] = hi ? mine[i] : got; }
#pragma unroll
        for (int q = 0; q < 4; ++q) {
            unsigned w0 = 0u, w1 = 0u;
#pragma unroll
            for (int e = 0; e < 4; ++e) { w0 |= (127u - (L0[4 * q + e] & 0x7Fu)) << (8 * e); w1 |= (127u - (L1[4 * q + e] & 0x7Fu)) << (8 * e); }
            *(LAS unsigned*)(idxs + 4 * q) = w0; *(LAS unsigned*)(idxs + 16 + 4 * q) = w1;
        }
        float f0[16], f1[16];
#pragma unroll
        for (int i = 0; i < 16; ++i) { f0[i] = sortable2f(L0[i] & ~0x7Fu); f1[i] = sortable2f(L1[i] & ~0x7Fu); }
        unsigned cnd[64];
        {
            int slot = 0;
#pragma unroll
            for (int i = 0; i < 16; ++i)
#pragma unroll
                for (int j = 0; j < 16; ++j)
                    if ((i + 1) * (j + 1) <= 16) { cnd[slot] = (f2sortable(f0[i] + f1[j]) & ~0xFFu) | (unsigned)(255 - (i * 16 + j)); ++slot; }
#pragma unroll
            for (int s = 50; s < 64; ++s) cnd[s] = 0u;
        }
        top16_of_64(cnd);
        LDS_FENCE();
        float e[16], esum = 0.f; const float vmax = sortable2f(cnd[0] & ~0xFFu);
#pragma unroll
        for (int k = 0; k < 16; ++k) { e[k] = __expf(sortable2f(cnd[k] & ~0xFFu) - vmax); esum += e[k]; }
        const float rinv = 1.0f / esum;
        if (hi == 0) {
            int* ip = RIDX + ((size_t)tok * 8 + h) * 16; float* gp = RG + ((size_t)tok * 8 + h) * 16;
#pragma unroll
            for (int k = 0; k < 16; ++k) { const unsigned pay = 255u - (cnd[k] & 0xFFu); const int i = pay >> 4, j = pay & 15;
                const int i1 = *(const LAS unsigned char*)(idxs + i), i2 = *(const LAS unsigned char*)(idxs + 16 + j);
                ip[k] = i1 * 128 + i2; gp[k] = e[k] * rinv; }
        }
    }
}

#define dppf(v, ctrl) __builtin_bit_cast(float, __builtin_amdgcn_update_dpp(0, __builtin_bit_cast(int, (v)), (ctrl), 0xf, 0xf, true))
typedef float f32x2v __attribute__((ext_vector_type(2)));
typedef float f32x4w __attribute__((ext_vector_type(4)));
__device__ __forceinline__ void phase_r3a(const Frame& F) {
    unsigned char* ws = (unsigned char*)F.ws;
    const bf16* HN = (const bf16*)(ws + WS_HN); const unsigned char* U8 = (const unsigned char*)(ws + WS_U8);
    const int* RIDX = (const int*)(ws + WS_RIDX); bf16* PWP = (bf16*)(ws + WS_PWP);
    const int lane = F.lane, g8 = lane >> 3, c8 = lane & 7, r15 = lane & 15, kg = lane >> 4;
    LAS unsigned char* stg = F.lds + F.wave * 4608;
    const int ngrp = (F.G % 8 == 0) ? 8 : 1, per = F.G / ngrp, grp = F.vcu / per, wx = (F.vcu % per) * NWAVES + F.wave, nwx = per * NWAVES;
    const __amdgpu_buffer_rsrc_t urs = __builtin_amdgcn_make_buffer_rsrc((void*)U8, 0, 16 * 1024 * 1024, 0x00020000);
#define R3A_IDX(tok) do { _Pragma("unroll") for (int i = 0; i < 16; ++i) idx[i] = RIDX[(size_t)(tok) * 128 + 8 * i + g8]; } while (0)
#define R3A_ROWS(UR, HV, tok) do { _Pragma("unroll") for (int i = 0; i < 16; ++i) UR[i] = __builtin_bit_cast(u32x4, __builtin_amdgcn_raw_buffer_load_b128(urs, idx[i] * 128 + c8 * 16, x * (16384 * 128), 0)); \
        const bf16* hp_ = HN + (size_t)(tok) * 1024 + 128 * x + 32 * kg; _Pragma("unroll") for (int s = 0; s < 4; ++s) HV[s] = *(const u32x4*)(hp_ + 8 * s); } while (0)
#define R3A_PROC(UR, HV, tok) do { \
        long hb8[4]; \
        _Pragma("unroll") for (int s = 0; s < 4; ++s) { const u32x4 a = HV[s]; int w0 = 0, w1 = 0; \
            w0 = __builtin_amdgcn_cvt_pk_fp8_f32(bflo(a.x) * 8.f, bfhi(a.x) * 8.f, w0, false); w0 = __builtin_amdgcn_cvt_pk_fp8_f32(bflo(a.y) * 8.f, bfhi(a.y) * 8.f, w0, true); \
            w1 = __builtin_amdgcn_cvt_pk_fp8_f32(bflo(a.z) * 8.f, bfhi(a.z) * 8.f, w1, false); w1 = __builtin_amdgcn_cvt_pk_fp8_f32(bflo(a.w) * 8.f, bfhi(a.w) * 8.f, w1, true); \
            hb8[s] = (long)(((unsigned long long)(unsigned)w1 << 32) | (unsigned long long)(unsigned)w0); } \
        _Pragma("unroll") for (int j = 0; j < 8; ++j) { \
            LAS unsigned char* sb = stg + (j & 1) * 2304; \
            *(LAS u32x4*)(sb + g8 * 144 + c8 * 16) = UR[2 * j]; *(LAS u32x4*)(sb + (8 + g8) * 144 + c8 * 16) = UR[2 * j + 1];        \
            const u32x4 q0 = *(const LAS u32x4*)(sb + r15 * 144 + 32 * kg), q1 = *(const LAS u32x4*)(sb + r15 * 144 + 32 * kg + 16); \
            f32x4w acc = {0.f, 0.f, 0.f, 0.f}; \
            acc = __builtin_amdgcn_mfma_f32_16x16x32_fp8_fp8((long)(((unsigned long long)q0.y << 32) | q0.x), hb8[0], acc, 0, 0, 0); \
            acc = __builtin_amdgcn_mfma_f32_16x16x32_fp8_fp8((long)(((unsigned long long)q0.w << 32) | q0.z), hb8[1], acc, 0, 0, 0); \
            acc = __builtin_amdgcn_mfma_f32_16x16x32_fp8_fp8((long)(((unsigned long long)q1.y << 32) | q1.x), hb8[2], acc, 0, 0, 0); \
            acc = __builtin_amdgcn_mfma_f32_16x16x32_fp8_fp8((long)(((unsigned long long)q1.w << 32) | q1.z), hb8[3], acc, 0, 0, 0); \
            if (r15 == 0) { u32x2 pw_; pw_.x = pk2(acc[0], acc[1]); pw_.y = pk2(acc[2], acc[3]); *(u32x2*)(PWP + ((size_t)x * MT + (tok)) * 128 + j * 16 + 4 * kg) = pw_; } } } while (0)
    for (int x = grp; x < 8; x += ngrp) {
        if (wx >= MT) continue;
        int idx[16]; u32x4 ur0[16], ur1[16], hv0[4], hv1[4];
        const int tlast = wx + ((MT - 1 - wx) / nwx) * nwx;
        R3A_IDX(wx); R3A_ROWS(ur0, hv0, wx);
        { const int t1 = min(wx + nwx, tlast); R3A_IDX(t1); R3A_ROWS(ur1, hv1, t1); }
        { const int t2 = min(wx + 2 * nwx, tlast); R3A_IDX(t2); }
#pragma unroll 1
        for (int t = wx; t < MT; t += 2 * nwx) {
            const int t2 = min(t + 2 * nwx, tlast), t3 = min(t + 3 * nwx, tlast), t4 = min(t + 4 * nwx, tlast);
            R3A_PROC(ur0, hv0, t);
            R3A_ROWS(ur0, hv0, t2);
            R3A_IDX(t3);
            if (t + nwx < MT) R3A_PROC(ur1, hv1, t + nwx);
            R3A_ROWS(ur1, hv1, t3);
            R3A_IDX(t4);
        }
    }
#undef R3A_IDX
#undef R3A_ROWS
#undef R3A_PROC
}
__device__ __forceinline__ void phase_r3f(const Frame& F) {
    unsigned char* ws = (unsigned char*)F.ws;
    const bf16* PWP = (const bf16*)(ws + WS_PWP); const int* RIDX = (const int*)(ws + WS_RIDX); const float* RG = (const float*)(ws + WS_RG);
    const float* SU = (const float*)(ws + WS_SU); const float* SV = (const float*)(ws + WS_SV); float* PW = (float*)(ws + WS_PW);
    const int gt = F.vcu * NTHREADS + F.tid, NGT = F.G * NTHREADS;
    for (int p4 = gt; p4 < MT * 128 / 4; p4 += NGT) {
        u32x2 pv[8];
#pragma unroll
        for (int x = 0; x < 8; ++x) pv[x] = *(const u32x2*)(PWP + ((size_t)x * MT * 128) + (size_t)p4 * 4);
        f32x4 s = {0.f, 0.f, 0.f, 0.f};
#pragma unroll
        for (int x = 0; x < 8; ++x) { s.x += bflo(pv[x].x); s.y += bfhi(pv[x].x); s.z += bflo(pv[x].y); s.w += bfhi(pv[x].y); }
        const u32x4 iv = *(const u32x4*)(RIDX + (size_t)p4 * 4); const f32x4 g = *(const f32x4*)(RG + (size_t)p4 * 4);
        f32x4 o;
        s = s * 0.125f;
        o.x = gelu_tanh(s.x * SU[iv.x]) * g.x * SV[iv.x]; o.y = gelu_tanh(s.y * SU[iv.y]) * g.y * SV[iv.y];
        o.z = gelu_tanh(s.z * SU[iv.z]) * g.z * SV[iv.z]; o.w = gelu_tanh(s.w * SU[iv.w]) * g.w * SV[iv.w];
        *(f32x4*)(PW + (size_t)p4 * 4) = o;
    }
}
__device__ __forceinline__ void phase_r3b(const Frame& F, const Params& P, const bool dry) {
    unsigned char* ws = (unsigned char*)F.ws;
    const unsigned char* V8 = (const unsigned char*)(ws + WS_V8);
    const int* RIDX = (const int*)(ws + WS_RIDX); const float* PW = (const float*)(ws + WS_PW);
    float* X = P.out;
    const int lane = F.lane, g8 = lane >> 3, c8 = lane & 7;
    const int ngrp = (F.G % 8 == 0) ? 8 : 1, per = F.G / ngrp, grp = F.vcu / per, wx = (F.vcu % per) * NWAVES + F.wave, nwx = per * NWAVES;
    const __amdgpu_buffer_rsrc_t vrs = __builtin_amdgcn_make_buffer_rsrc((void*)V8, 0, 16 * 1024 * 1024, 0x00020000);
#define R3B_ROW(e) __builtin_bit_cast(u32x4, __builtin_amdgcn_raw_buffer_load_b128(vrs, (e) * 128 + c8 * 16, x * (16384 * 128), 0))
    const __amdgpu_buffer_rsrc_t irs = __builtin_amdgcn_make_buffer_rsrc((void*)RIDX, 0, MT * 128 * 4, 0x00020000), prs = __builtin_amdgcn_make_buffer_rsrc((void*)PW, 0, MT * 128 * 4, 0x00020000),
                                 xrs = __builtin_amdgcn_make_buffer_rsrc((void*)X, 0, MT * 1024 * 4, 0x00020000);
#define R3B_ACC(vrv, wbase) do { _Pragma("unroll") for (int i = 0; i < 8; ++i) { const unsigned ww[4] = {vrv[i].x, vrv[i].y, vrv[i].z, vrv[i].w}; \
        _Pragma("unroll") for (int q = 0; q < 4; ++q) { const f32x2v a = __builtin_amdgcn_cvt_pk_f32_fp8((int)ww[q], false), b = __builtin_amdgcn_cvt_pk_f32_fp8((int)ww[q], true); \
            acc[4 * q] += w[(wbase) + i] * a.x; acc[4 * q + 1] += w[(wbase) + i] * a.y; acc[4 * q + 2] += w[(wbase) + i] * b.x; acc[4 * q + 3] += w[(wbase) + i] * b.y; } } } while (0)
#define R3B_IDX8(tb_, so_, idv) do { _Pragma("unroll") for (int q = 0; q < 2; ++q) { const u32x4 iv = __builtin_bit_cast(u32x4, __builtin_amdgcn_raw_buffer_load_b128(irs, (tb_) + 16 * q, (so_), 0)); idv[4 * q] = (int)iv.x; idv[4 * q + 1] = (int)iv.y; idv[4 * q + 2] = (int)iv.z; idv[4 * q + 3] = (int)iv.w; } } while (0)
#define R3B_W8(tb_, so_, wv) do { _Pragma("unroll") for (int q = 0; q < 2; ++q) { const f32x4 wq = __builtin_bit_cast(f32x4, __builtin_amdgcn_raw_buffer_load_b128(prs, (tb_) + 16 * q, (so_), 0)); wv[4 * q] = wq.x; wv[4 * q + 1] = wq.y; wv[4 * q + 2] = wq.z; wv[4 * q + 3] = wq.w; } } while (0)
    for (int x = grp; x < 8; x += ngrp) {
        if (wx * 8 >= MT) continue;
        int ia[8], ib[8]; float w[16];
        { const int tb0 = min(wx * 8 + g8, MT - 1) * 512; R3B_IDX8(tb0, 0, ia); R3B_IDX8(tb0, 32, ib); { float* wlo = w; R3B_W8(tb0, 0, wlo); } { float* whi = w + 8; R3B_W8(tb0, 32, whi); } }
        u32x4 va[8], vb[8];
#pragma unroll
        for (int i = 0; i < 8; ++i) va[i] = R3B_ROW(ia[i]);
        float acc[16];
#pragma unroll
        for (int c = 0; c < 16; ++c) acc[c] = 0.f;
#pragma unroll 1
        for (int t0 = wx * 8; t0 < MT; t0 += nwx * 8) {
            const int t = min(t0 + g8, MT - 1); const bool tv = t0 + g8 < MT;
            const int t0n = (t0 + nwx * 8 < MT) ? t0 + nwx * 8 : t0, tnx = min(t0n + g8, MT - 1);
            const int tb = t * 512, tbn = tnx * 512, xo = t * 4096 + 512 * x + 64 * c8;
            f32x4 xv[4];
#pragma unroll 1
            for (int ch = 0; ch < 8; ++ch) {
                const int tkb = (ch < 7) ? tb : tbn, so = (ch < 7) ? 64 * (ch + 1) : 0;
#pragma unroll
                for (int i = 0; i < 8; ++i) vb[i] = R3B_ROW(ib[i]);
                R3B_IDX8(tkb, so, ia);
                if (ch == 7) {
#pragma unroll
                    for (int q = 0; q < 4; ++q) xv[q] = __builtin_bit_cast(f32x4, __builtin_amdgcn_raw_buffer_load_b128(xrs, xo + 16 * q, 0, 0)); }
                R3B_ACC(va, 0);
                { float* wlo = w; R3B_W8(tkb, so, wlo); }
#pragma unroll
                for (int i = 0; i < 8; ++i) va[i] = R3B_ROW(ia[i]);
                R3B_IDX8(tkb, so + 32, ib);
                R3B_ACC(vb, 8);
                { float* whi = w + 8; R3B_W8(tkb, so + 32, whi); }
            }
            if (tv && !dry) {
#pragma unroll
                for (int q = 0; q < 4; ++q) { f32x4 o = xv[q]; o.x += acc[4 * q]; o.y += acc[4 * q + 1]; o.z += acc[4 * q + 2]; o.w += acc[4 * q + 3];
                    int so_ = xo + 16 * q; asm volatile("" : "+v"(so_)); __builtin_amdgcn_raw_buffer_store_b128(__builtin_bit_cast(u32x4, o), xrs, so_, 0, 0); } }
#pragma unroll
            for (int c = 0; c < 16; ++c) acc[c] = 0.f;
        }
    }
#undef R3B_IDX8
#undef R3B_W8
#undef R3B_ACC
#undef R3B_ROW
}

#ifndef PHASE_MASK
#define PHASE_MASK 0x3FFFFu
#endif
#define IN(k) (((PHASE_MASK >> (((k)) % NPH)) & 1u) && lo <= (k) && (k) < hi)
#define INR(k) (lo <= (k) && (k) < hi)
#define SEAM(k) do { if (INR(k) && INR((k) + 1)) xcd_barrier(bar); } while (0)
__device__ __forceinline__ void layer_body(const Frame& F0, const Params& P, const XcdBarrier& bar, const int layer0, const int lo, const int hi) {
    const int pb = layer0 * NPH;
#define DRY false
#define PH_BEGIN const Frame F = launder(F0); const int layer = launder_i(layer0); unsigned char* ws = (unsigned char*)F.ws; (void)layer; (void)ws;
    if (IN(pb + 0)) { PH_BEGIN phase_prep(F, P, layer); } SEAM(pb + 0);
    if (IN(pb + 1)) { PH_BEGIN
        pg8::Gemm g{(const pg8::bf16_t*)(ws + WS_XN), (const pg8::bf16_t*)(ws + WS_WIN) + (size_t)WA_ROW0 * 1024, MT, WA_N + 256, 1024};
        pg8::StaticOrder S; S.init(MT, WA_N + 256, F.G, (int)blockIdx.x);
        EpiSeg E{{(bf16*)(ws + WS_YC), 1024, 4, (bf16*)(ws + WS_XBC), 1536, 10, (bf16*)(ws + WS_MISC), 256, 11, (bf16*)(ws + WS_LX), 1024}};
        pg8::gemm_phase<EpiSeg, pg8::StaticOrder, true, true>(F.lds, g, S, E);
    } SEAM(pb + 1);
    if (IN(pb + 2)) { PH_BEGIN phase_s0(F, P, layer); } SEAM(pb + 2);
    if (IN(pb + 3)) { PH_BEGIN phase_s1(F, P, layer); } SEAM(pb + 3);
    if (IN(pb + 4)) { PH_BEGIN phase_s2(F, DRY); } SEAM(pb + 4);
    if (IN(pb + 5)) { PH_BEGIN phase_s3(F, P, layer, DRY); } SEAM(pb + 5);
    if (IN(pb + 6)) { PH_BEGIN
        pg8::Gemm g{(const pg8::bf16_t*)(ws + WS_XN), (const pg8::bf16_t*)(ws + WS_WIN) + (size_t)(WB_ROW0 + 256) * 1024, MT, WB_N + WC_N - 256, 1024};
        pg8::StaticOrder S; S.init(MT, WB_N + WC_N - 256, F.G, (int)blockIdx.x);
        EpiSeg E{{(bf16*)(ws + WS_LX) + 256, 1024, 3, (bf16*)(ws + WS_LG), 1024, 7, (bf16*)(ws + WS_Q), 1024, 11, (bf16*)(ws + WS_KV), 768}};
        pg8::gemm_phase<EpiSeg, pg8::StaticOrder, true, true>(F.lds, g, S, E);
    } SEAM(pb + 6);
    if (IN(pb + 7)) { PH_BEGIN phase_lru<1>(F, P, layer, false); __syncthreads(); phase_n0(F, P, layer, DRY); } SEAM(pb + 7);
    if (IN(pb + 8)) { PH_BEGIN phase_lru2(F); __syncthreads(); phase_n1(F, P, layer); } SEAM(pb + 8);
    if (IN(pb + 9)) { PH_BEGIN phase_lru<3>(F, P, layer, DRY); __syncthreads(); phase_n2(F, P, layer, DRY); } SEAM(pb + 9);
    if (IN(pb + 10)) { PH_BEGIN
        pg8::Gemm g{(const pg8::bf16_t*)(ws + WS_YA8), (const pg8::bf16_t*)(ws + WS_WMRG), 4 * MT, 6144, 512};
        MergeOrder S{F.G, F.vcu};
        EpiMerge E{ws + WS_GBUF + (size_t)blockIdx.x * 131072, ws + WS_MBUF + (size_t)blockIdx.x * 131072, (bf16*)(ws + WS_MERGED)};
        pg8::gemm_phase<EpiMerge, MergeOrder, true, true, true>(F.lds, g, S, E);
    } SEAM(pb + 10);
    if (IN(pb + 11)) { PH_BEGIN
        const float* xin = layer == 0 ? P.in[0] : P.out;
        pg8::Gemm g{(const pg8::bf16_t*)(ws + WS_MERGED), (const pg8::bf16_t*)(ws + WS_WOUT), MT, 1024, 1024};
        pg8::StaticOrder S; S.init(MT, 1024, F.G, (int)blockIdx.x);
        EpiResid E{xin, P.out, DRY};
        pg8::gemm_phase<EpiResid, pg8::StaticOrder, true, true>(F.lds, g, S, E);
    } SEAM(pb + 11);
    if (IN(pb + 12)) { PH_BEGIN phase_r0(F, P, layer); } SEAM(pb + 12);
    if (IN(pb + 13)) { PH_BEGIN
        pg8::Gemm g{(const pg8::bf16_t*)(ws + WS_HN), (const pg8::bf16_t*)(ws + WS_WQ), MT, 2048, 1024};
        pg8::StaticOrder S; S.init(MT, 2048, F.G, (int)blockIdx.x);
        EpiSeg E{{(bf16*)(ws + WS_PQ), 2048, 8, (bf16*)(ws + WS_PQ), 2048, 8, (bf16*)(ws + WS_PQ), 2048, 8, (bf16*)(ws + WS_PQ), 2048}};
        pg8::gemm_phase<EpiSeg, pg8::StaticOrder, true, true>(F.lds, g, S, E);
    } SEAM(pb + 13);
    if (IN(pb + 14)) { PH_BEGIN phase_r2(F); } SEAM(pb + 14);
    if (IN(pb + 15)) { PH_BEGIN phase_r3a(F); } SEAM(pb + 15);
    if (IN(pb + 16)) { PH_BEGIN phase_r3f(F); } SEAM(pb + 16);
    if (IN(pb + 17)) { PH_BEGIN phase_r3b(F, P, DRY); } SEAM(pb + 17);
}
__global__ void __launch_bounds__(NTHREADS, 2) hybrid_fwd(Params P) {
    extern __shared__ __attribute__((aligned(16))) unsigned char lds_raw[];
    Frame F;
    F.lds = (LAS unsigned char*)lds_raw; F.ws = (__attribute__((address_space(1))) unsigned char*)P.ws;
    F.tid = threadIdx.x; F.lane = F.tid & 63; F.wave = __builtin_amdgcn_readfirstlane(F.tid >> 6);
    F.G = gridDim.x; { const int bx = blockIdx.x; F.vcu = (F.G % 8 == 0) ? (bx % 8) * (F.G / 8) + bx / 8 : bx; }
    F.gw = F.vcu * NWAVES + F.wave; F.NGW = F.G * NWAVES;
    volatile LAS unsigned* MISC = (volatile LAS unsigned*)(F.lds + MISC_OFF);
    if (F.tid < 16) MISC[F.tid] = 0u;
    __syncthreads();
    unsigned* barw = (unsigned*)(P.ws + WS_CTL) + 1024;
    XcdBarrier bar; bar.bar = barw; bar.x = 0; bar.st = MISC + 8;
    const int lo = P.ph_lo, hi = P.ph_hi;
    if (hi - lo > 1) bar = xcd_barrier_post(barw, MISC + 8);
    layer_body(F, P, bar, 0, lo, hi);
    if (DBG_LAYERS > 1) layer_body(F, P, bar, 1, lo, hi);
}

extern "C" void kernel_launch(void* const* d_in, const int* in_sizes, int n_in, void* d_out, int out_size, void* d_ws, size_t ws_size, hipStream_t stream) {
    static int grid = 0;
    if (grid == 0) {
        if (n_in != 32 || out_size != MT * DM || ws_size < WS_END) { fprintf(stderr, "kernel_launch: unexpected problem shape (n_in %d, out %d, ws %zu)\n", n_in, out_size, ws_size); grid = -1; return; }
        int dev = 0, cus = 0, per_cu = 0;
        if (hipGetDevice(&dev) != hipSuccess || hipDeviceGetAttribute(&cus, hipDeviceAttributeMultiprocessorCount, dev) != hipSuccess) { grid = -1; return; }
        if (hipFuncSetAttribute((const void*)hybrid_fwd, hipFuncAttributeMaxDynamicSharedMemorySize, LDS_BYTES) != hipSuccess) { fprintf(stderr, "kernel_launch: hipFuncSetAttribute failed\n"); grid = -1; return; }
        if (hipOccupancyMaxActiveBlocksPerMultiprocessor(&per_cu, (const void*)hybrid_fwd, NTHREADS, LDS_BYTES) != hipSuccess || per_cu < 1)
            fprintf(stderr, "kernel_launch: note: occupancy query reports %d workgroups per CU\n", per_cu);
        (void)hipGetLastError();
        grid = cus;
    }
    if (grid < 0) return;
    (void)hipMemsetAsync((char*)d_ws + WS_CTL, 0, CTL_ZERO_BYTES, stream);
    Params p{};
#ifndef REP_MASK
#define REP_MASK 0u
#endif
    p.rep_mask = REP_MASK; p.pad = 0;
    for (int i = 0; i < 32; ++i) p.in[i] = (const float*)d_in[i];
    p.out = (float*)d_out; p.ws = (unsigned char*)d_ws;
    const int nph = DBG_LAYERS * NPH;
#if ONE_LAUNCH
    p.ph_lo = 0; p.ph_hi = nph;
    hipLaunchKernelGGL(hybrid_fwd, dim3(grid), dim3(NTHREADS), LDS_BYTES, stream, p);
#else
    for (int k = 0; k < nph; ++k) { p.ph_lo = k; p.ph_hi = k + 1; hipLaunchKernelGGL(hybrid_fwd, dim3(grid), dim3(NTHREADS), LDS_BYTES, stream, p); }
#endif
}
```

```cpp
#define ONE_LAUNCH 1
#define DBG_BRANCH 7
#define DBG_PEER 1
#define DBG_LAYERS 2
#define REP_MASK 0u
#define PADV 0
#include <hip/hip_runtime.h>
#include <cstdio>
#include <cstdint>

#ifndef ONE_LAUNCH
#define ONE_LAUNCH 0
#endif
#ifndef DBG_BRANCH
#define DBG_BRANCH 7
#endif
#ifndef DBG_PEER
#define DBG_PEER 1
#endif
#ifndef DBG_LAYERS
#define DBG_LAYERS 2
#endif
namespace pg8 {
#define PG8_LAS __attribute__((address_space(3)))
typedef unsigned short bf16_t;
typedef short bf16x8 __attribute__((ext_vector_type(8)));
typedef float f32x4 __attribute__((ext_vector_type(4)));
typedef unsigned u32x4 __attribute__((ext_vector_type(4)));
constexpr int BM = 256, BK = 64, HALF = 128, HTB = HALF * BK * 2  , STAGE_BYTES = 8 * HTB, NXCD = 8, WGM = 8;

__host__ __device__ __forceinline__ int lds_byte(int r, int c) { const int st = (r >> 4) * 2 + (c >> 5), rr = r & 15, cc = c & 31, ob = rr * 64 + cc * 2; return st * 1024 + (ob ^ (((ob >> 9) & 1) << 5)); }
__host__ __device__ __forceinline__ void stage_rc(int b, int& R, int& C) { const int st = b / 1024, sb = b % 1024, swz = sb ^ (((sb >> 9) & 1) << 5); R = (st >> 1) * 16 + swz / 64; C = (st & 1) * 32 + (swz % 64) / 2; }
__host__ __device__ __forceinline__ int perm32(int rho) { const int n = rho >> 4, i = rho & 15; return 8 * (i >> 2) + 4 * n + (i & 3); }

struct Unit { int pm, pn; };
struct Gemm { const bf16_t* A; const bf16_t* Bt; int M, N, K; };

struct StaticOrder {
    int nM, nN, nwg, G, c;
    __host__ __device__ void init(int M, int N, int G_, int c_) { nM = M / BM; nN = N / BM; nwg = nM * nN; G = G_; c = c_; }
    __host__ __device__ bool next(int i, Unit& u) const {
        const long L = (long)i * G + c; if (L >= nwg) return false;
        int wgid = (int)L; { const int q = nwg / NXCD, r = nwg % NXCD, xcd = wgid % NXCD, off = wgid / NXCD; wgid = (xcd < r ? xcd * (q + 1) : r * (q + 1) + (xcd - r) * q) + off; }
        const int nig = WGM * nN, gid = wgid / nig, fm = gid * WGM, gsz = (nM - fm) < WGM ? (nM - fm) : WGM;
        u.pm = fm + ((wgid % nig) % gsz); u.pn = (wgid % nig) / gsz; return true;
    }
    __device__ __forceinline__ void a_ready(const Unit&) const {}
    __device__ __forceinline__ void done(const Unit&) const {}
};

__device__ __forceinline__ unsigned cvt_pk_bf16(float lo, float hi) { unsigned r; asm volatile("v_cvt_pk_bf16_f32 %0, %1, %2" : "=v"(r) : "v"(lo), "v"(hi)); return r; }
typedef int i32x4 __attribute__((ext_vector_type(4)));
typedef int i32x8 __attribute__((ext_vector_type(8)));
__device__ __forceinline__ i32x8 cat8(bf16x8 a, bf16x8 b) { return __builtin_shufflevector(__builtin_bit_cast(i32x4, a), __builtin_bit_cast(i32x4, b), 0, 1, 2, 3, 4, 5, 6, 7); }
template <class Epi, class Sched, bool ALIGN_EPI = false, bool SP2 = false, bool FP8 = false>
__device__ __forceinline__ void gemm_phase(PG8_LAS unsigned char* lds, const Gemm g, const Sched& S, const Epi& E) {
    int tid_ = threadIdx.x; asm volatile("" : "+v"(tid_)); const int tid = tid_ & 511, wid = __builtin_amdgcn_readfirstlane(tid >> 6), lane = tid & 63, wr = wid >> 2, wc = wid & 3, fr = lane & 15, fq = lane >> 4;
    const int K = g.K; int nt_ = K / BK; if constexpr (FP8) asm volatile("" : "+s"(nt_));
    const int nt = nt_;
    unsigned voffA[2], voffB[2];
#pragma unroll
    for (int i = 0; i < 2; ++i) { int R, C; stage_rc(tid * 16 + i * 8192, R, C); const int Rb = Epi::PERM ? ((R & ~31) + perm32(R & 31)) : R;
        voffA[i] = (unsigned)(R * K + C) * 2u; voffB[i] = (unsigned)(Rb * K + C) * 2u; }
    const size_t kstep = (size_t)(BK * 2);
    const size_t hstep = (size_t)HALF * K * 2;
    const size_t tstep = 2 * hstep;
    const unsigned ldsw = (unsigned)wid * 1024u;
    const int aoff = lds_byte(wr * 64 + fr, fq * 8), boff = lds_byte(wc * 32 + fr, fq * 8);
#define PG8_SA(b, h) (((b) * 2 + (h)) * HTB)
#define PG8_SB(b, h) ((4 + (b) * 2 + (h)) * HTB)
#define PG8_STAGE(bufoff, gbase, voff) do { _Pragma("unroll") for (int _i = 0; _i < 2; ++_i) \
        __builtin_amdgcn_global_load_lds((const unsigned*)((const char*)(gbase) + (voff)[_i]), (PG8_LAS unsigned*)(lds + (bufoff) + ldsw + _i * 8192), 16, 0, 0); } while (0)
#define PG8_LDA(dst, b, h) do { _Pragma("unroll") for (int m = 0; m < 4; ++m) _Pragma("unroll") for (int k = 0; k < 2; ++k) dst[m][k] = *(const PG8_LAS bf16x8*)(lds + PG8_SA(b, h) + aoff + m * 2048 + k * 1024); } while (0)
#define PG8_LDB(dst, b, h) do { _Pragma("unroll") for (int n = 0; n < 2; ++n) _Pragma("unroll") for (int k = 0; k < 2; ++k) dst[n][k] = *(const PG8_LAS bf16x8*)(lds + PG8_SB(b, h) + boff + n * 2048 + k * 1024); } while (0)
#define PG8_MMA(ai, bj, At, Bt) do { __builtin_amdgcn_s_setprio(1); _Pragma("unroll") for (int m = 0; m < 4; ++m) _Pragma("unroll") for (int n = 0; n < 2; ++n) { \
        if constexpr (FP8) { const i32x8 a8_ = cat8(Bt[n][0], Bt[n][1]), b8_ = cat8(At[m][0], At[m][1]); \
            asm volatile("v_mfma_scale_f32_16x16x128_f8f6f4 %0, %1, %2, %0, %3, %4 op_sel_hi:[0,0,0]" : "+v"(acc[ai][bj][m][n]) : "v"(a8_), "v"(b8_), "v"(sclw), "v"(scla)); } \
        else { _Pragma("unroll") for (int k = 0; k < 2; ++k) acc[ai][bj][m][n] = __builtin_amdgcn_mfma_f32_16x16x32_bf16(Bt[n][k], At[m][k], acc[ai][bj][m][n], 0, 0, 0); } } \
        __builtin_amdgcn_s_setprio(0); } while (0)
    int sclw = 121, scla = 127; asm volatile("" : "+v"(sclw), "+v"(scla));
#define PG8_WAIT_V(n) asm volatile("s_waitcnt vmcnt(" #n ")" ::: "memory")
#define PG8_WAIT_L(n) asm volatile("s_waitcnt lgkmcnt(" #n ")" ::: "memory")
#define PG8_BAR __builtin_amdgcn_s_barrier()
#define PG8_SCHED __builtin_amdgcn_sched_barrier(0)
    Unit cur, nxt; int ui = 0;
    if (!S.next(0, cur)) return;
    f32x4 acc[2][2][4][2];
#pragma unroll
    for (int a = 0; a < 2; ++a)
#pragma unroll
        for (int b = 0; b < 2; ++b)
#pragma unroll
            for (int m = 0; m < 4; ++m)
#pragma unroll
                for (int n = 0; n < 2; ++n) acc[a][b][m][n] = (f32x4){0.f, 0.f, 0.f, 0.f};
    bf16x8 At[4][2], B0[2][2], B1[2][2];
    const char* cA = (const char*)g.A + (size_t)cur.pm * tstep; const char* cB = (const char*)g.Bt + (size_t)cur.pn * tstep;
    S.a_ready(cur);
    if constexpr (SP2) {
        PG8_STAGE(PG8_SB(0, 0), cB, voffB); PG8_STAGE(PG8_SB(0, 1), cB + hstep, voffB); PG8_STAGE(PG8_SA(0, 0), cA, voffA); PG8_STAGE(PG8_SA(0, 1), cA + hstep, voffA);
        if (wr == 1) PG8_BAR;
        PG8_WAIT_V(2); PG8_BAR;
        PG8_STAGE(PG8_SB(1, 0), cB + kstep, voffB); PG8_STAGE(PG8_SA(1, 0), cA + kstep, voffA); PG8_STAGE(PG8_SB(1, 1), cB + hstep + kstep, voffB);
        PG8_WAIT_V(6); PG8_BAR;
    } else {
        PG8_STAGE(PG8_SB(0, 0), cB, voffB); PG8_STAGE(PG8_SA(0, 0), cA, voffA); PG8_STAGE(PG8_SB(0, 1), cB + hstep, voffB); PG8_STAGE(PG8_SA(0, 1), cA + hstep, voffA);
        if (wr == 1) PG8_BAR;
        PG8_WAIT_V(4); PG8_BAR;
        PG8_STAGE(PG8_SB(1, 0), cB + kstep, voffB); PG8_STAGE(PG8_SA(1, 0), cA + kstep, voffA); PG8_STAGE(PG8_SB(1, 1), cB + hstep + kstep, voffB);
        PG8_WAIT_V(6); PG8_BAR;
    }
    for (;;) {
        const bool has_next = S.next(ui + 1, nxt);
        const char* nA = has_next ? (const char*)g.A + (size_t)nxt.pm * tstep : cA; const char* nB = has_next ? (const char*)g.Bt + (size_t)nxt.pn * tstep : cB;
        for (int t = 0; t < nt; t += 2) {
            const bool last = (t == nt - 2);
            const char* a1 = cA + (size_t)(t + 1) * kstep;
            const char* a2 = last ? nA : cA + (size_t)(t + 2) * kstep; const char* b2 = last ? nB : cB + (size_t)(t + 2) * kstep;
            const char* a3 = a2 + kstep; const char* b3 = b2 + kstep;
            if (last && has_next) S.a_ready(nxt);
            if constexpr (SP2) {
            PG8_LDB(B0, 0, 0); PG8_LDB(B1, 0, 1); PG8_SCHED; PG8_LDA(At, 0, 0); PG8_STAGE(PG8_SA(1, 1), a1 + hstep, voffA);
            PG8_WAIT_V(8); PG8_WAIT_L(0); PG8_BAR; PG8_MMA(0, 0, At, B0); PG8_MMA(0, 1, At, B1); PG8_BAR; PG8_SCHED;
            PG8_LDA(At, 0, 1); PG8_STAGE(PG8_SB(0, 0), b2, voffB); PG8_STAGE(PG8_SB(0, 1), b2 + hstep, voffB); PG8_STAGE(PG8_SA(0, 0), a2, voffA);
            PG8_WAIT_V(8); PG8_WAIT_L(0); PG8_BAR; PG8_MMA(1, 0, At, B0); PG8_MMA(1, 1, At, B1); PG8_BAR; PG8_SCHED;
            PG8_LDB(B0, 1, 0); PG8_LDB(B1, 1, 1); PG8_SCHED; PG8_LDA(At, 1, 0); PG8_STAGE(PG8_SA(0, 1), a2 + hstep, voffA);
            PG8_WAIT_V(8); PG8_WAIT_L(0); PG8_BAR; PG8_MMA(0, 0, At, B0); PG8_MMA(0, 1, At, B1); PG8_BAR; PG8_SCHED;
            PG8_LDA(At, 1, 1); PG8_STAGE(PG8_SB(1, 0), b3, voffB); PG8_STAGE(PG8_SB(1, 1), b3 + hstep, voffB); PG8_STAGE(PG8_SA(1, 0), a3, voffA);
            PG8_WAIT_V(8); PG8_WAIT_L(0); PG8_BAR; PG8_MMA(1, 0, At, B0); PG8_MMA(1, 1, At, B1); PG8_BAR; PG8_SCHED;
            } else {
            PG8_LDB(B0, 0, 0); PG8_SCHED; PG8_LDA(At, 0, 0); PG8_STAGE(PG8_SA(1, 1), a1 + hstep, voffA);
            PG8_WAIT_L(8); PG8_BAR; PG8_WAIT_L(0); PG8_MMA(0, 0, At, B0); PG8_BAR; PG8_SCHED;
            PG8_LDB(B1, 0, 1); PG8_STAGE(PG8_SB(0, 0), b2, voffB);
            PG8_BAR; PG8_WAIT_L(0); PG8_MMA(0, 1, At, B1); PG8_BAR;
            PG8_LDA(At, 0, 1); PG8_STAGE(PG8_SA(0, 0), a2, voffA);
            PG8_BAR; PG8_WAIT_L(0); PG8_MMA(1, 0, At, B0); PG8_BAR; PG8_SCHED;
            PG8_STAGE(PG8_SB(0, 1), b2 + hstep, voffB);
            PG8_WAIT_V(6); PG8_BAR; PG8_MMA(1, 1, At, B1); PG8_BAR;
            PG8_LDB(B0, 1, 0); PG8_SCHED; PG8_LDA(At, 1, 0); PG8_STAGE(PG8_SA(0, 1), a2 + hstep, voffA);
            PG8_WAIT_L(8); PG8_BAR; PG8_WAIT_L(0); PG8_MMA(0, 0, At, B0); PG8_BAR; PG8_SCHED;
            PG8_LDB(B1, 1, 1); PG8_STAGE(PG8_SB(1, 0), b3, voffB);
            PG8_BAR; PG8_WAIT_L(0); PG8_MMA(0, 1, At, B1); PG8_BAR;
            PG8_LDA(At, 1, 1); PG8_STAGE(PG8_SA(1, 0), a3, voffA);
            PG8_BAR; PG8_WAIT_L(0); PG8_MMA(1, 0, At, B0); PG8_BAR; PG8_SCHED;
            PG8_STAGE(PG8_SB(1, 1), b3 + hstep, voffB);
            PG8_WAIT_V(6); PG8_BAR; PG8_MMA(1, 1, At, B1); PG8_BAR;
            }
        }
        if constexpr (FP8) asm volatile("s_nop 15\n\ts_nop 7" ::: "memory");
        if constexpr (ALIGN_EPI) { if (wr == 0) PG8_BAR; }
        if constexpr (!Epi::AFTER_DRAIN) { E(acc, cur, wr, wc, fr, fq); S.done(cur); }
        if (!has_next) break;
#pragma unroll
        for (int a = 0; a < 2; ++a)
#pragma unroll
            for (int b = 0; b < 2; ++b)
#pragma unroll
                for (int m = 0; m < 4; ++m)
#pragma unroll
                    for (int n = 0; n < 2; ++n) acc[a][b][m][n] = (f32x4){0.f, 0.f, 0.f, 0.f};
        cur = nxt; cA = nA; cB = nB; ++ui;
        if constexpr (ALIGN_EPI) { if (wr == 1) PG8_BAR; }
    }
    PG8_WAIT_V(0);
    if constexpr (!ALIGN_EPI) { if (wr == 0) PG8_BAR; }
    PG8_BAR;
    if constexpr (Epi::AFTER_DRAIN) { E.fused(acc, cur, wr, wc, fr, fq, lds, wid, lane); S.done(cur); }
#undef PG8_SA
#undef PG8_SB
#undef PG8_STAGE
#undef PG8_LDA
#undef PG8_LDB
#undef PG8_MMA
#undef PG8_WAIT_V
#undef PG8_WAIT_L
#undef PG8_BAR
#undef PG8_SCHED
}
}

#define LAS __attribute__((address_space(3)))
typedef unsigned short bf16;
typedef short bf16x8 __attribute__((ext_vector_type(8)));
typedef float f32x4 __attribute__((ext_vector_type(4)));
typedef float f32x16 __attribute__((ext_vector_type(16)));
typedef unsigned u32x4 __attribute__((ext_vector_type(4)));
typedef unsigned u32x2 __attribute__((ext_vector_type(2)));
typedef unsigned long long u64;

constexpr int NB = 4, SEQ = 8192, DM = 1024, MT = NB * SEQ, DEPTH = 2, INCOLS = 9536;
constexpr float EPS = 1e-6f;
constexpr int NPH = 18;
constexpr int NTHREADS = 512, NWAVES = 8;

constexpr size_t MiB = 1u << 20;
constexpr size_t WS_CTL = 0, CTL_ZERO_BYTES = 64 * 1024;
constexpr size_t WS_SK = 1 * MiB;
constexpr size_t WS_W1K = 2 * MiB, WS_W1V = 3 * MiB;
constexpr size_t WS_W2K = 4 * MiB, WS_W2V = 4 * MiB + 64 * 1024;
constexpr size_t WS_WRT = 4 * MiB + 128 * 1024, WS_WIT = 4 * MiB + 256 * 1024;
constexpr size_t WS_DEC = 4 * MiB + 512 * 1024;
constexpr size_t WS_WIN = 8 * MiB;
constexpr size_t WS_WMRG = 21 * MiB;
constexpr size_t WS_WOUT = 33 * MiB;
constexpr size_t WS_WQ = 35 * MiB;
constexpr size_t WS_XN = 40 * MiB, WS_YA = 104 * MiB, WS_YB = 168 * MiB, WS_YC = 232 * MiB;
constexpr size_t WS_R = 296 * MiB;
constexpr size_t WS_END = 512 * MiB;
constexpr size_t WS_XBC = WS_R, WS_STATES = WS_R, WS_MISC = WS_R + 200 * MiB;
constexpr size_t WS_XT = WS_YA, WS_BM = WS_YB, WS_CM = WS_YB + 16 * MiB, WS_BT = WS_YB + 32 * MiB, WS_DTV = WS_YB + 48 * MiB;
constexpr size_t WS_LX = WS_R + 96 * MiB, WS_LG = WS_YB, WS_AGG = WS_R + 160 * MiB, WS_CARRY = WS_R + 164 * MiB;
constexpr size_t WS_Q = WS_YA, WS_KV = WS_R, WS_KC = WS_R + 48 * MiB, WS_KS = WS_R + 56 * MiB, WS_KW = WS_YC,
                 WS_VST = WS_YC + 8 * MiB, WS_VWT = WS_YC + 16 * MiB, WS_KCMP = WS_YC + 24 * MiB, WS_VCMPT = WS_YC + 25 * MiB;
constexpr size_t WS_MERGED = WS_R, WS_GBUF = WS_R + 128 * MiB, WS_MBUF = WS_R + 96 * MiB;
constexpr size_t WS_HN8S = WS_YC + 32 * MiB;
constexpr size_t WS_XN8 = WS_R + 168 * MiB, WS_YC8 = WS_R + 64 * MiB, WS_YA8 = WS_XN, WS_YB8 = WS_XN + 32 * MiB;
constexpr int A8_TILE(size_t off) { return (int)((off - WS_YA8) / (256 * 1024)); }
constexpr size_t WS_HN = WS_XN, WS_PQ = WS_YA, WS_RIDX = WS_YC, WS_RG = WS_YC + 16 * MiB, WS_UB = WS_R, WS_VB = WS_R + 32 * MiB,
                 WS_U8 = WS_R, WS_V8 = WS_R + 16 * MiB, WS_SU = WS_R + 32 * MiB, WS_SV = WS_R + 33 * MiB, WS_PW = WS_R + 34 * MiB, WS_PWP = WS_R + 64 * MiB;

constexpr int WA_ROW0 = 0, WA_N = 2816;
constexpr int WB_ROW0 = 2816, WB_N = 2048;
constexpr int WC_ROW0 = 4864, WC_N = 1792;

constexpr int LDS_BYTES = 160 * 1024;
constexpr int MISC_OFF = LDS_BYTES - 256;

struct Params { const float* in[32]; float* out; unsigned char* ws; int ph_lo, ph_hi; unsigned rep_mask; int pad; };

__device__ __forceinline__ unsigned pk4_fp8(float a, float b, float c, float d) {
    int w = 0; w = __builtin_amdgcn_cvt_pk_fp8_f32(__builtin_amdgcn_fmed3f(a, -448.f, 448.f), __builtin_amdgcn_fmed3f(b, -448.f, 448.f), w, false);
    w = __builtin_amdgcn_cvt_pk_fp8_f32(__builtin_amdgcn_fmed3f(c, -448.f, 448.f), __builtin_amdgcn_fmed3f(d, -448.f, 448.f), w, true); return (unsigned)w; }

__device__ __forceinline__ float wave_sum(float v) {
#pragma unroll
    for (int o = 1; o < 64; o <<= 1) v += __shfl_xor(v, o);
    return v;
}
__device__ __forceinline__ float half_sum(float v) {
#pragma unroll
    for (int o = 1; o < 32; o <<= 1) v += __shfl_xor(v, o);
    return v;
}
typedef float f32x2_t __attribute__((ext_vector_type(2)));
typedef __bf16 bf16x2_t __attribute__((ext_vector_type(2)));
__device__ __forceinline__ unsigned pk2(float lo, float hi) { const f32x2_t v = {lo, hi}; const bf16x2_t b = __builtin_convertvector(v, bf16x2_t); return __builtin_bit_cast(unsigned, b); }
__device__ __forceinline__ float bflo(unsigned u) { return __builtin_bit_cast(float, u << 16); }
__device__ __forceinline__ float bfhi(unsigned u) { return __builtin_bit_cast(float, u & 0xffff0000u); }
__device__ __forceinline__ float bf1(bf16 h) { return __builtin_bit_cast(float, (unsigned)h << 16); }
__device__ __forceinline__ bf16 f2bf(float f) { return (bf16)(pk2(f, 0.f) & 0xffffu); }
__device__ __forceinline__ float frcp(float x) { return __builtin_amdgcn_rcpf(x); }
__device__ __forceinline__ float frsq(float x) { return __builtin_amdgcn_rsqf(x); }
__device__ __forceinline__ float sigmoidf_(float x) { return frcp(1.0f + __builtin_amdgcn_exp2f(-1.4426950408889634f * x)); }
__device__ __forceinline__ float gelu_tanh(float x) { const float u = 1.5957691216057308f * (x + 0.044715f * x * x * x); return x * frcp(1.0f + __builtin_amdgcn_exp2f(-1.4426950408889634f * u)); }
__device__ __forceinline__ float softplusf_(float x) { return x > 20.f ? x : log1pf(__expf(x)); }
__device__ __forceinline__ int crow(int i, int hi) { return (i & 3) + 8 * (i >> 2) + 4 * hi; }
#define MFMA32(a, b, c) __builtin_amdgcn_mfma_f32_32x32x16_bf16((a), (b), (c), 0, 0, 0)
__device__ __forceinline__ f32x16 zero16() { f32x16 z; for (int i = 0; i < 16; ++i) z[i] = 0.f; return z; }
__device__ __forceinline__ bf16x8 ld8(const bf16* p) { return *(const bf16x8*)p; }
__device__ __forceinline__ bf16x8 lds8(const LAS unsigned char* p) { return *(const LAS bf16x8*)p; }
#define LDS_FENCE() asm volatile("s_waitcnt lgkmcnt(0)" ::: "memory")

#define XB_TMO      128
#define XB_XCNT(j)  (256  + 64 * (j))
#define XB_XSUB(j)  (1280 + 64 * (j))
#define XB_XGEN(j)  (2304 + 64 * (j))
#define XB_TOP      3328
#define XB_TOPGEN   3392
#define XCD_BAR_WORDS 3456
#define XB_SPIN_CAP (1u << 22)
__device__ __forceinline__ unsigned xb_ld(unsigned* p)              { return __hip_atomic_load(p, __ATOMIC_RELAXED, __HIP_MEMORY_SCOPE_AGENT); }
__device__ __forceinline__ unsigned xb_add(unsigned* p, unsigned v) { return __hip_atomic_fetch_add(p, v, __ATOMIC_RELAXED, __HIP_MEMORY_SCOPE_AGENT); }
__device__ __forceinline__ unsigned xb_xcc_id() { return (unsigned)__builtin_amdgcn_s_getreg((3 << 11) | 20) & 0xFu; }
#define XB_SPIN(cond, bar) do { unsigned _sp = 0; while (cond) { __builtin_amdgcn_s_sleep(1); \
    if ((++_sp & 255u) == 0u) { if (xb_ld(&(bar)[XB_TMO])) break; if (_sp > XB_SPIN_CAP) { atomicAdd(&(bar)[XB_TMO], 1u); break; } } } } while (0)
struct XcdBarrier { unsigned* bar; unsigned x; volatile LAS unsigned* st; };
__device__ __forceinline__ XcdBarrier xcd_barrier_post(unsigned* bar, volatile LAS unsigned* st) {
    XcdBarrier b; b.bar = bar; b.x = xb_xcc_id(); b.st = st;
    if (threadIdx.x == 0) (void)xb_add(&bar[XB_XCNT(b.x)], 1u);
    return b;
}
__device__ __forceinline__ void xcd_barrier_complete(unsigned* bar, unsigned x, unsigned& nloc, unsigned& nx) {
    const unsigned G = gridDim.x * gridDim.y * gridDim.z;
    unsigned sum, cnt, mine, sp = 0u;
    for (;;) {
        sum = 0u; cnt = 0u; mine = 0u;
#pragma unroll
        for (unsigned j = 0; j < 16; ++j) { const unsigned c = xb_ld(&bar[XB_XCNT(j)]); sum += c; cnt += (c > 0u) ? 1u : 0u; mine = (j == x) ? c : mine; }
        if (sum == G) break;
        __builtin_amdgcn_s_sleep(1);
        if ((++sp & 255u) == 0u) { if (xb_ld(&bar[XB_TMO])) break; if (sp > XB_SPIN_CAP) { atomicAdd(&bar[XB_TMO], 1u); break; } }
    }
    nloc = mine > 0u ? mine : 1u; nx = cnt > 0u ? cnt : 1u;
}
__device__ __forceinline__ void xcd_barrier(const XcdBarrier& b) {
    asm volatile("s_waitcnt vmcnt(0)" ::: "memory");
    __syncthreads();
    if (threadIdx.x == 0) {
        unsigned* bar = b.bar;
        __builtin_amdgcn_s_waitcnt(0);
        unsigned nloc = b.st[0], nx = b.st[1];
        if (nloc == 0u) { xcd_barrier_complete(bar, b.x, nloc, nx); b.st[0] = nloc; b.st[1] = nx; }
        const unsigned old = xb_add(&bar[XB_XSUB(b.x)], 1u);
        const unsigned gen = old / nloc;
        if (old + 1u == (gen + 1u) * nloc) {
            __builtin_amdgcn_fence(__ATOMIC_RELEASE, "agent");
            asm volatile("s_waitcnt vmcnt(0)" ::: "memory");
            const unsigned og = xb_add(&bar[XB_TOP], 1u);
            const unsigned tg = og / nx;
            if (og + 1u == (tg + 1u) * nx) xb_add(&bar[XB_TOPGEN], 1u);
            else XB_SPIN(xb_ld(&bar[XB_TOPGEN]) == tg, bar);
            __builtin_amdgcn_fence(__ATOMIC_ACQUIRE, "agent");
            xb_add(&bar[XB_XGEN(b.x)], 1u);
            asm volatile("s_waitcnt vmcnt(0)" ::: "memory");
        } else {
            XB_SPIN(xb_ld(&bar[XB_XGEN(b.x)]) == gen, bar);
            __builtin_amdgcn_fence(__ATOMIC_ACQUIRE, "agent");
            asm volatile("s_waitcnt vmcnt(0)" ::: "memory");
        }
    }
    __syncthreads();
}

struct Frame {
    LAS unsigned char* lds;
    __attribute__((address_space(1))) unsigned char* ws;
    int tid, lane, wave, vcu, G, gw, NGW;
};

__device__ __forceinline__ Frame launder(const Frame& F) {
    Frame G = F; asm volatile("" : "+s"(G.ws)); int t = G.tid; asm volatile("" : "+v"(t)); t &= 511; G.tid = t; G.lane = t & 63; int w = G.wave; asm volatile("" : "+s"(w)); G.wave = w & 7; return G; }
__device__ __forceinline__ int launder_i(int v) { asm volatile("" : "+s"(v)); return v; }
template <bool F8>
__device__ __forceinline__ void tr_item(const float* W, int K, int ldn, int c0, bf16* WT, int r0, int nblk, LAS float* scr, int item, int lane) {
    const int kb = item / nblk, nb = item % nblk, k0 = 64 * kb, n0 = 64 * nb;
    const int lr = lane >> 4, lc = (lane & 15) * 4;
#pragma unroll 8
    for (int i = 0; i < 16; ++i) { const int kk = 4 * i + lr; const f32x4 v = *(const f32x4*)(W + (size_t)(k0 + kk) * ldn + c0 + n0 + lc);
        LAS float* s = scr + kk * 65 + lc; s[0] = v.x; s[1] = v.y; s[2] = v.z; s[3] = v.w; }
    LDS_FENCE();
    const int c = lane & 7;
#pragma unroll
    for (int j = 0; j < 8; ++j) { const int n = (lane >> 3) + 8 * j; const LAS float* s = scr + (8 * c) * 65 + n;
        if constexpr (F8) { u32x2 o; o.x = pk4_fp8(64.f * s[0 * 65], 64.f * s[1 * 65], 64.f * s[2 * 65], 64.f * s[3 * 65]); o.y = pk4_fp8(64.f * s[4 * 65], 64.f * s[5 * 65], 64.f * s[6 * 65], 64.f * s[7 * 65]);
            *(u32x2*)((unsigned char*)WT + (size_t)(r0 + n0 + n) * K + k0 + 8 * c) = o; }
        else { u32x4 o; o.x = pk2(s[0 * 65], s[1 * 65]); o.y = pk2(s[2 * 65], s[3 * 65]); o.z = pk2(s[4 * 65], s[5 * 65]); o.w = pk2(s[6 * 65], s[7 * 65]);
            *(u32x4*)(WT + (size_t)(r0 + n0 + n) * K + k0 + 8 * c) = o; } }
    LDS_FENCE();
}
template <bool F8 = false>
__device__ __forceinline__ void tr_matrix(const Frame& F, const float* W, int K, int ldn, int c0, int ncols, bf16* WT, int r0, int rot) {
    LAS float* scr = (LAS float*)(F.lds + F.wave * 16640);
    const int nblk = ncols / 64, nitems = (K / 64) * nblk;
    int start = F.gw - (rot % F.NGW); if (start < 0) start += F.NGW;
    for (int it = start; it < nitems; it += F.NGW) tr_item<F8>(W, K, ldn, c0, WT, r0, nblk, scr, it, F.lane);
}
template <bool F8 = false>
__device__ __forceinline__ void rms_rows(const Frame& F, const float* x, const float* g, bf16* o, unsigned char* o8 = nullptr, const float s8 = 1.0f) {
    f32x4 gg[4];
#pragma unroll
    for (int j = 0; j < 4; ++j) gg[j] = ((const f32x4*)g)[F.lane + 64 * j];
    for (int m0 = F.gw; m0 < MT; m0 += 2 * F.NGW) {
        const int m1 = m0 + F.NGW; const bool has1 = m1 < MT;
        const f32x4* xr0 = (const f32x4*)(x + (size_t)m0 * DM) + F.lane; const f32x4* xr1 = (const f32x4*)(x + (size_t)(has1 ? m1 : m0) * DM) + F.lane;
        f32x4 v0[4], v1[4]; float s0 = 0.f, s1 = 0.f;
#pragma unroll
        for (int j = 0; j < 4; ++j) { v0[j] = xr0[64 * j]; v1[j] = xr1[64 * j]; }
#pragma unroll
        for (int j = 0; j < 4; ++j) { s0 += (v0[j].x * v0[j].x + v0[j].y * v0[j].y) + (v0[j].z * v0[j].z + v0[j].w * v0[j].w); s1 += (v1[j].x * v1[j].x + v1[j].y * v1[j].y) + (v1[j].z * v1[j].z + v1[j].w * v1[j].w); }
#pragma unroll
        for (int of = 1; of < 64; of <<= 1) { s0 += __shfl_xor(s0, of); s1 += __shfl_xor(s1, of); }
        const float sc0 = frsq(s0 * (1.0f / DM) + EPS), sc1 = frsq(s1 * (1.0f / DM) + EPS);
        u32x2* o0 = (u32x2*)(o + (size_t)m0 * DM) + F.lane; u32x2* o1 = (u32x2*)(o + (size_t)m1 * DM) + F.lane;
#pragma unroll
        for (int j = 0; j < 4; ++j) {
            u32x2 w; w.x = pk2(v0[j].x * sc0 * gg[j].x, v0[j].y * sc0 * gg[j].y); w.y = pk2(v0[j].z * sc0 * gg[j].z, v0[j].w * sc0 * gg[j].w); o0[64 * j] = w;
            if constexpr (F8) ((unsigned*)(o8 + (size_t)m0 * DM))[F.lane + 64 * j] = pk4_fp8(v0[j].x * sc0 * gg[j].x * s8, v0[j].y * sc0 * gg[j].y * s8, v0[j].z * sc0 * gg[j].z * s8, v0[j].w * sc0 * gg[j].w * s8);
            if (has1) { u32x2 w1; w1.x = pk2(v1[j].x * sc1 * gg[j].x, v1[j].y * sc1 * gg[j].y); w1.y = pk2(v1[j].z * sc1 * gg[j].z, v1[j].w * sc1 * gg[j].w); o1[64 * j] = w1;
                if constexpr (F8) ((unsigned*)(o8 + (size_t)m1 * DM))[F.lane + 64 * j] = pk4_fp8(v1[j].x * sc1 * gg[j].x * s8, v1[j].y * sc1 * gg[j].y * s8, v1[j].z * sc1 * gg[j].z * s8, v1[j].w * sc1 * gg[j].w * s8); } }
    }
}
__device__ __forceinline__ void phase_prep(const Frame& F, const Params& P, int layer) {
    unsigned char* ws = (unsigned char*)F.ws;
    const float* w_in = P.in[3] + (size_t)layer * DM * INCOLS;
    bf16* WIN = (bf16*)(ws + WS_WIN); bf16* WMRG = (bf16*)(ws + WS_WMRG);
    int rot = 0;
    tr_matrix(F, w_in, 1024, INCOLS, 3888, 1024, WIN, 0, rot); rot += 256;
    tr_matrix(F, w_in, 1024, INCOLS, 4912, 1536, WIN, 1024, rot); rot += 384;
    tr_matrix(F, w_in, 1024, INCOLS, 1840, 1024, WIN, WB_ROW0, rot); rot += 256;
    tr_matrix(F, w_in, 1024, INCOLS, 2864, 1024, WIN, WB_ROW0 + 1024, rot); rot += 256;
    tr_matrix(F, w_in, 1024, INCOLS, 0, 1024, WIN, WC_ROW0, rot); rot += 256;
    tr_matrix(F, w_in, 1024, INCOLS, 1024, 768, WIN, WC_ROW0 + 1024, rot); rot += 192;
    tr_matrix<true>(F, w_in, 1024, INCOLS, 6464, 3072, WMRG, 0, rot); rot += 768;
    for (int b = 0; b < 3; ++b) { tr_matrix<true>(F, P.in[25] + ((size_t)layer * 3 + b) * DM * DM, 1024, 1024, 0, 1024, WMRG, 3072 + 1024 * b, rot); rot += 256; }
    tr_matrix(F, P.in[26] + (size_t)layer * DM * DM, 1024, 1024, 0, 1024, (bf16*)(ws + WS_WOUT), 0, rot); rot += 256;
    tr_matrix(F, P.in[28] + (size_t)layer * DM * 2048, 1024, 2048, 0, 2048, (bf16*)(ws + WS_WQ), 0, rot); rot += 512;
    tr_matrix(F, P.in[8] + (size_t)layer * 2048 * 256, 2048, 256, 0, 256, (bf16*)(ws + WS_W1K), 0, rot); rot += 128;
    tr_matrix(F, P.in[10] + (size_t)layer * 2048 * 256, 2048, 256, 0, 256, (bf16*)(ws + WS_W1V), 0, rot); rot += 128;
    tr_matrix(F, P.in[9] + (size_t)layer * 256 * 64, 256, 64, 0, 64, (bf16*)(ws + WS_W2K), 0, rot); rot += 4;
    tr_matrix(F, P.in[11] + (size_t)layer * 256 * 64, 256, 64, 0, 64, (bf16*)(ws + WS_W2V), 0, rot); rot += 4;
    for (int h = 0; h < 16; ++h) {
        tr_matrix(F, P.in[14] + ((size_t)layer * 16 + h) * 4096, 64, 64, 0, 64, (bf16*)(ws + WS_WRT) + h * 4096, 0, rot); rot += 1;
        tr_matrix(F, P.in[16] + ((size_t)layer * 16 + h) * 4096, 64, 64, 0, 64, (bf16*)(ws + WS_WIT) + h * 4096, 0, rot); rot += 1;
    }
    const int gt = F.vcu * NTHREADS + F.tid, NGT = F.G * NTHREADS;
    for (int e = gt; e < 256 * 1024; e += NGT) {
        const int n = e >> 10, k = e & 1023; float v = 0.f;
        if (n < 16) v = w_in[(size_t)k * INCOLS + 6448 + n]; else if (n < 64) v = w_in[(size_t)k * INCOLS + 1792 + (n - 16)];
        WIN[(size_t)(2560 + n) * 1024 + k] = f2bf(v);
    }
    { const float* sk = P.in[29] + (size_t)layer * 262144; bf16* o = (bf16*)(ws + WS_SK);
      for (int e = gt; e < 262144; e += NGT) o[e] = f2bf(sk[e]); }
    const float* xin = layer == 0 ? P.in[0] : P.out;
    rms_rows<true>(F, xin, P.in[2] + (size_t)layer * DM, (bf16*)(ws + WS_XN), ws + WS_XN8);
}

struct Seg3 { bf16* p0; int ld0, t0; bf16* p1; int ld1, t1; bf16* p2; int ld2, t2; bf16* p3; int ld3; };
struct EpiSeg {
    static constexpr bool PERM = true, AFTER_DRAIN = false;
    Seg3 s;
    __device__ __forceinline__ void operator()(const pg8::f32x4 (&acc)[2][2][4][2], const pg8::Unit& u, int wr, int wc, int fr, int fq) const {
        bf16* base; int ld, ct;
        if (u.pn < s.t0) { base = s.p0; ld = s.ld0; ct = u.pn; } else if (u.pn < s.t1) { base = s.p1; ld = s.ld1; ct = u.pn - s.t0; } else if (u.pn < s.t2) { base = s.p2; ld = s.ld2; ct = u.pn - s.t1; } else { base = s.p3; ld = s.ld3; ct = u.pn - s.t2; }
        const int row0 = u.pm * 256 + wr * 64 + fr, col0 = ct * 256 + wc * 32 + 8 * fq;
#pragma unroll
        for (int ai = 0; ai < 2; ++ai)
#pragma unroll
            for (int m = 0; m < 4; ++m) { bf16* rowp = base + (size_t)(row0 + ai * 128 + m * 16) * ld + col0;
#pragma unroll
                for (int bj = 0; bj < 2; ++bj) { const pg8::f32x4 v0 = acc[ai][bj][m][0], v1 = acc[ai][bj][m][1];
                    u32x4 w; w.x = pk2(v0[0], v0[1]); w.y = pk2(v0[2], v0[3]); w.z = pk2(v1[0], v1[1]); w.w = pk2(v1[2], v1[3]);
                    *(u32x4*)(rowp + bj * 128) = w; } }
    }
};
struct EpiResid {
    static constexpr bool PERM = true, AFTER_DRAIN = false;
    const float* xres; float* out; bool dry;
    __device__ __forceinline__ void operator()(const pg8::f32x4 (&acc)[2][2][4][2], const pg8::Unit& u, int wr, int wc, int fr, int fq) const {
        const int row0 = u.pm * 256 + wr * 64 + fr, col0 = u.pn * 256 + wc * 32 + 8 * fq;
#pragma unroll
        for (int ai = 0; ai < 2; ++ai)
#pragma unroll
            for (int m = 0; m < 4; ++m) { const size_t off = (size_t)(row0 + ai * 128 + m * 16) * DM + col0;
#pragma unroll
                for (int bj = 0; bj < 2; ++bj) {
                    const f32x4 x0 = *(const f32x4*)(xres + off + bj * 128), x1 = *(const f32x4*)(xres + off + bj * 128 + 4);
                    const pg8::f32x4 v0 = acc[ai][bj][m][0], v1 = acc[ai][bj][m][1];
                    f32x4 o0, o1; o0.x = x0.x + v0[0]; o0.y = x0.y + v0[1]; o0.z = x0.z + v0[2]; o0.w = x0.w + v0[3];
                    o1.x = x1.x + v1[0]; o1.y = x1.y + v1[1]; o1.z = x1.z + v1[2]; o1.w = x1.w + v1[3];
                    if (!dry) { *(f32x4*)(out + off + bj * 128) = o0; *(f32x4*)(out + off + bj * 128 + 4) = o1; } } }
    }
};
constexpr int MRG_NEN = ((DBG_BRANCH >> 0) & 1) + ((DBG_BRANCH >> 1) & 1) + ((DBG_BRANCH >> 2) & 1);
__host__ __device__ constexpr int mrg_branch(int k) {
    int c = 0; for (int b = 0; b < 3; ++b) if ((DBG_BRANCH >> b) & 1) { if (c == k) return b; ++c; } return 0;
}
__host__ __device__ constexpr int mrg_atile(int b) { return b == 0 ? A8_TILE(WS_YA8) : (b == 1 ? A8_TILE(WS_YB8) : A8_TILE(WS_YC8)); }
struct MergeOrder {
    int G, c;
    __device__ __forceinline__ bool next(int i, pg8::Unit& u) const {
        constexpr int NSUB = 2 * MRG_NEN;
        const int tile = (i / NSUB) * G + c; if (tile >= 512) return false;
        const int sub = i % NSUB, k = sub >> 1, b = (k == 0) ? mrg_branch(0) : (k == 1 ? mrg_branch(1) : mrg_branch(2));
        const int tm = tile >> 2, tn = tile & 3;
        if (sub & 1) { u.pm = mrg_atile(b) + tm; u.pn = 12 + 4 * b + tn; } else { u.pm = A8_TILE(WS_XN8) + tm; u.pn = 4 * b + tn; }
        return true;
    }
    __device__ __forceinline__ void a_ready(const pg8::Unit&) const {}
    __device__ __forceinline__ void done(const pg8::Unit&) const {}
};
struct EpiMerge {
    static constexpr bool PERM = true, AFTER_DRAIN = false;
    unsigned char* gbuf; unsigned char* mbuf; bf16* merged;
    __device__ __forceinline__ void operator()(const pg8::f32x4 (&acc)[2][2][4][2], const pg8::Unit& u, int wr, int wc, int fr, int fq) const {
        const int tid = threadIdx.x;
        const bool isbr = u.pn >= 12;
        const __amdgpu_buffer_rsrc_t grs = __builtin_amdgcn_make_buffer_rsrc((void*)gbuf, 0, 131072, 0x00020000);
        const __amdgpu_buffer_rsrc_t mrs = __builtin_amdgcn_make_buffer_rsrc((void*)mbuf, 0, 131072, 0x00020000);
        int vo_ = tid * 16; asm volatile("" : "+v"(vo_)); const int vo = vo_;
        if (!isbr) {
#pragma unroll
            for (int q = 0; q < 16; ++q) { const int ai = q >> 3, m = (q >> 1) & 3, bj = q & 1;
                const pg8::f32x4 v0 = acc[ai][bj][m][0], v1 = acc[ai][bj][m][1];
                u32x4 w; w.x = pk2(sigmoidf_(v0[0]), sigmoidf_(v0[1])); w.y = pk2(sigmoidf_(v0[2]), sigmoidf_(v0[3]));
                w.z = pk2(sigmoidf_(v1[0]), sigmoidf_(v1[1])); w.w = pk2(sigmoidf_(v1[2]), sigmoidf_(v1[3]));
                int so = vo + q * 8192; asm volatile("" : "+v"(so));
                __builtin_amdgcn_raw_buffer_store_b128(w, grs, so, 0, 0); }
        } else {
            const int b = (u.pn - 12) >> 2, tm = u.pm - (b == 0 ? mrg_atile(0) : (b == 1 ? mrg_atile(1) : mrg_atile(2))), tn = u.pn & 3;
            const bool first = (b == mrg_branch(0)), last = (b == mrg_branch(MRG_NEN - 1));
            const int row0 = tm * 256 + wr * 64 + fr, col0 = tn * 256 + wc * 32 + 8 * fq;
#pragma unroll
            for (int hb = 0; hb < 2; ++hb) {
                u32x4 gw[8], pv[8];
#pragma unroll
                for (int k = 0; k < 8; ++k) gw[k] = __builtin_bit_cast(u32x4, __builtin_amdgcn_raw_buffer_load_b128(grs, vo, (8 * hb + k) * 8192, 0));
                if (!first) {
#pragma unroll
                    for (int k = 0; k < 8; ++k) pv[k] = __builtin_bit_cast(u32x4, __builtin_amdgcn_raw_buffer_load_b128(mrs, vo, (8 * hb + k) * 8192, 0)); }
#pragma unroll
                for (int k = 0; k < 8; ++k) { const int q = 8 * hb + k, ai = q >> 3, m = (q >> 1) & 3, bj = q & 1;
                    const pg8::f32x4 v0 = acc[ai][bj][m][0], v1 = acc[ai][bj][m][1];
                    f32x4 r0, r1;
                    r0.x = v0[0] * bflo(gw[k].x); r0.y = v0[1] * bfhi(gw[k].x); r0.z = v0[2] * bflo(gw[k].y); r0.w = v0[3] * bfhi(gw[k].y);
                    r1.x = v1[0] * bflo(gw[k].z); r1.y = v1[1] * bfhi(gw[k].z); r1.z = v1[2] * bflo(gw[k].w); r1.w = v1[3] * bfhi(gw[k].w);
                    if (!first) { r0.x += bflo(pv[k].x); r0.y += bfhi(pv[k].x); r0.z += bflo(pv[k].y); r0.w += bfhi(pv[k].y); r1.x += bflo(pv[k].z); r1.y += bfhi(pv[k].z); r1.z += bflo(pv[k].w); r1.w += bfhi(pv[k].w); }
                    u32x4 w; w.x = pk2(r0.x, r0.y); w.y = pk2(r0.z, r0.w); w.z = pk2(r1.x, r1.y); w.w = pk2(r1.z, r1.w);
                    if (last) *(u32x4*)(merged + (size_t)(row0 + ai * 128 + m * 16) * DM + col0 + bj * 128) = w;
                    else { int so = vo + q * 8192; asm volatile("" : "+v"(so)); __builtin_amdgcn_raw_buffer_store_b128(w, mrs, so, 0, 0); } }
                asm volatile("" ::: "memory");
            }
        }
    }
};

__device__ __forceinline__ void phase_s0(const Frame& F, const Params& P, int layer) {
    unsigned char* ws = (unsigned char*)F.ws;
    const bf16* raw = (const bf16*)(ws + WS_XBC); const bf16* misc = (const bf16*)(ws + WS_MISC);
    bf16* XT = (bf16*)(ws + WS_XT); bf16* BM = (bf16*)(ws + WS_BM); bf16* CM = (bf16*)(ws + WS_CM); bf16* BT = (bf16*)(ws + WS_BT);
    float* DTV = (float*)(ws + WS_DTV);
    const float* cw = P.in[19] + (size_t)layer * 4 * 1536; const float* cb = P.in[20] + (size_t)layer * 1536;
    const float* dtb = P.in[21] + layer * 16;
    LAS bf16* tile = (LAS bf16*)F.lds;
    const int tl = F.tid >> 3, cg = F.tid & 7;
    const int per_wg = (NB * 128 * 12 + F.G - 1) / F.G, i0 = F.vcu * per_wg, i1 = min(NB * 128 * 12, i0 + per_wg);
    f32x4 wgt[2][10]; int wct = -1;
    u32x4 xn[2][4];
#define S0_ISSUE(idx_) do { const int ct2_ = (idx_) >> 9, tok_ = (idx_) & 511, t_ = (tok_ & 127) * 64 + tl; _Pragma("unroll") for (int h2 = 0; h2 < 2; ++h2) { const int ch0 = (ct2_ + 12 * h2) * 64 + cg * 8; \
        _Pragma("unroll") for (int k = 0; k < 4; ++k) { const int ts = t_ - 3 + k; const u32x4 v_ = *(const u32x4*)(raw + (size_t)((tok_ >> 7) * SEQ + (ts < 0 ? 0 : ts)) * 1536 + ch0); xn[h2][k] = (ts >= 0) ? v_ : (u32x4){0u, 0u, 0u, 0u}; } } } while (0)
    if (i0 < i1) S0_ISSUE(i0);
#pragma unroll 1
    for (int idx = i0; idx < i1; ++idx) {
        const int ct2 = idx >> 9, tok = idx & 511, b = tok >> 7, tt = tok & 127;
        const int t = tt * 64 + tl;
        LAS bf16* tbuf = tile + (idx & 1) * 8192;
        if (ct2 != wct) { wct = ct2;
#pragma unroll
            for (int h2 = 0; h2 < 2; ++h2) { const int ch0 = (ct2 + 12 * h2) * 64 + cg * 8;
#pragma unroll
                for (int k = 0; k < 4; ++k) { wgt[h2][2 * k] = *(const f32x4*)(cw + k * 1536 + ch0); wgt[h2][2 * k + 1] = *(const f32x4*)(cw + k * 1536 + ch0 + 4); }
                wgt[h2][8] = *(const f32x4*)(cb + ch0); wgt[h2][9] = *(const f32x4*)(cb + ch0 + 4); } }
        u32x4 xr[2][4];
#pragma unroll
        for (int h2 = 0; h2 < 2; ++h2)
#pragma unroll
            for (int k = 0; k < 4; ++k) xr[h2][k] = xn[h2][k];
        if (idx + 1 < i1) S0_ISSUE(idx + 1);
#pragma unroll
        for (int h2 = 0; h2 < 2; ++h2) { const int ct = ct2 + 12 * h2, ch0 = ct * 64 + cg * 8;
            float o[8] = {wgt[h2][8].x, wgt[h2][8].y, wgt[h2][8].z, wgt[h2][8].w, wgt[h2][9].x, wgt[h2][9].y, wgt[h2][9].z, wgt[h2][9].w};
#pragma unroll
            for (int k = 0; k < 4; ++k) { const u32x4 x = xr[h2][k]; const f32x4 w0 = wgt[h2][2 * k], w1 = wgt[h2][2 * k + 1];
                o[0] += bflo(x.x) * w0.x; o[1] += bfhi(x.x) * w0.y; o[2] += bflo(x.y) * w0.z; o[3] += bfhi(x.y) * w0.w;
                o[4] += bflo(x.z) * w1.x; o[5] += bfhi(x.z) * w1.y; o[6] += bflo(x.w) * w1.z; o[7] += bfhi(x.w) * w1.w; }
#pragma unroll
            for (int e = 0; e < 8; ++e) o[e] = o[e] * sigmoidf_(o[e]);
            if (ct >= 16) {
                u32x4 pw; pw.x = pk2(o[0], o[1]); pw.y = pk2(o[2], o[3]); pw.z = pk2(o[4], o[5]); pw.w = pk2(o[6], o[7]);
                bf16* dst = (ct < 20) ? BM : CM; const int col = ch0 - ((ct < 20) ? 1024 : 1280);
                *(u32x4*)(dst + (size_t)(b * SEQ + t) * 256 + col) = pw;
            }
            if (ct < 20) {
#pragma unroll
                for (int e = 0; e < 8; ++e) tbuf[h2 * 4096 + (cg * 8 + e) * 64 + ((((tl >> 3) ^ cg) << 3) | (tl & 7))] = f2bf(o[e]);
            }
        }
        __syncthreads();
#pragma unroll
        for (int h2 = 0; h2 < 2; ++h2) { const int ct = ct2 + 12 * h2;
            if (ct < 20) {
                const int r = F.tid >> 3, chk = F.tid & 7;
                const u32x4 v = *(const LAS u32x4*)(tbuf + h2 * 4096 + r * 64 + ((chk ^ ((r >> 3) & 7)) << 3));
                bf16* dst = (ct < 16) ? (XT + ((size_t)b * 1024 + ct * 64 + r) * SEQ) : (BT + ((size_t)b * 256 + (ct - 16) * 64 + r) * SEQ);
                *(u32x4*)(dst + tt * 64 + chk * 8) = v;
            }
        }
    }
#undef S0_ISSUE
    __syncthreads();
    const int gt = F.vcu * NTHREADS + F.tid, NGT = F.G * NTHREADS;
    for (int e = gt; e < MT * 16; e += NGT) { const int m = e >> 4, h = e & 15; DTV[e] = softplusf_(bf1(misc[(size_t)m * 256 + h]) + dtb[h]); }
}

__device__ __forceinline__ float ssd_chunk_scan(const float* DTV, int b, int t0, int hh, float A, int lane, LAS float* acs, LAS float* dts) {
    const float dt0 = DTV[(size_t)(b * SEQ + t0 + lane) * 16 + hh], dt1 = DTV[(size_t)(b * SEQ + t0 + 64 + lane) * 16 + hh];
    float x0 = dt0 * A, x1 = dt1 * A;
#pragma unroll
    for (int o = 1; o < 64; o <<= 1) { const float y0 = __shfl_up(x0, o), y1 = __shfl_up(x1, o); if (lane >= o) { x0 += y0; x1 += y1; } }
    const float tot0 = __shfl(x0, 63); x1 += tot0;
    const float aend = __shfl(x1, 63);
    acs[lane] = x0; acs[lane + 64] = x1; dts[lane] = dt0; dts[lane + 64] = dt1;
    LDS_FENCE();
    return aend;
}

__device__ __forceinline__ void phase_s1(const Frame& F, const Params& P, int layer) {
    unsigned char* ws = (unsigned char*)F.ws;
    const bf16* XT = (const bf16*)(ws + WS_XT); const bf16* BT = (const bf16*)(ws + WS_BT); const float* DTV = (const float*)(ws + WS_DTV);
    bf16* ST = (bf16*)(ws + WS_STATES); float* DEC = (float*)(ws + WS_DEC);
    const float* alog = P.in[22] + layer * 16;
    LAS float* acs = (LAS float*)(F.lds) + F.wave * 256; LAS float* dts = acs + 128;
    const int lane = F.lane, hi = lane >> 5, l31 = lane & 31;
    for (int u = F.vcu; u < NB * 64 * 2; u += F.G) {
        const int g = u & 1, c = (u >> 1) & 63, b = u >> 7, hh = g * 8 + F.wave, t0 = c * 128;
        const float A = -__expf(alog[hh]);
        const float aend = ssd_chunk_scan(DTV, b, t0, hh, A, lane, acs, dts);
        if (lane == 0) DEC[(b * 64 + c) * 16 + hh] = __expf(aend);
        f32x16 acc[2][4];
#pragma unroll
        for (int i = 0; i < 2; ++i)
#pragma unroll
            for (int j = 0; j < 4; ++j) acc[i][j] = zero16();
#pragma unroll 4
        for (int ks = 0; ks < 8; ++ks) {
            const int l0 = 16 * ks + 8 * hi;
            float wv[8];
#pragma unroll
            for (int e = 0; e < 8; ++e) wv[e] = dts[l0 + e] * __expf(aend - acs[l0 + e]);
            bf16x8 af[2], bfr[4];
#pragma unroll
            for (int pt = 0; pt < 2; ++pt) {
                const u32x4 xr = *(const u32x4*)(XT + ((size_t)b * 1024 + hh * 64 + pt * 32 + l31) * SEQ + t0 + l0);
                u32x4 o; o.x = pk2(bflo(xr.x) * wv[0], bfhi(xr.x) * wv[1]); o.y = pk2(bflo(xr.y) * wv[2], bfhi(xr.y) * wv[3]);
                o.z = pk2(bflo(xr.z) * wv[4], bfhi(xr.z) * wv[5]); o.w = pk2(bflo(xr.w) * wv[6], bfhi(xr.w) * wv[7]);
                af[pt] = __builtin_bit_cast(bf16x8, o);
            }
#pragma unroll
            for (int nt = 0; nt < 4; ++nt) bfr[nt] = ld8(BT + ((size_t)b * 256 + g * 128 + nt * 32 + l31) * SEQ + t0 + l0);
#pragma unroll
            for (int pt = 0; pt < 2; ++pt)
#pragma unroll
                for (int nt = 0; nt < 4; ++nt) acc[pt][nt] = MFMA32(bfr[nt], af[pt], acc[pt][nt]);
        }
        bf16* sp = ST + ((size_t)((b * 64 + c) * 16 + hh)) * 8192;
#pragma unroll
        for (int pt = 0; pt < 2; ++pt)
#pragma unroll
            for (int nt = 0; nt < 4; ++nt)
#pragma unroll
                for (int q = 0; q < 4; ++q) { u32x2 o; o.x = pk2(acc[pt][nt][4 * q], acc[pt][nt][4 * q + 1]); o.y = pk2(acc[pt][nt][4 * q + 2], acc[pt][nt][4 * q + 3]);
                    *(u32x2*)(sp + (pt * 32 + l31) * 128 + nt * 32 + 8 * q + 4 * hi) = o; }
        LDS_FENCE();
    }
}

__device__ __forceinline__ void phase_s2(const Frame& F, const bool dry) {
    unsigned char* ws = (unsigned char*)F.ws;
    bf16* ST = (bf16*)(ws + WS_STATES); const float* DEC = (const float*)(ws + WS_DEC);
    const int gt = F.vcu * NTHREADS + F.tid, NGT = F.G * NTHREADS;
    for (int e = gt; e < NB * 16 * 2048; e += NGT) {
        const int b = e / 32768, rem = e % 32768, hh = rem / 2048, pn = rem % 2048;
        float run[4] = {0.f, 0.f, 0.f, 0.f};
        for (int c0 = 0; c0 < 64; c0 += 8) {
            u32x2 s[8]; float d[8];
#pragma unroll
            for (int k = 0; k < 8; ++k) { s[k] = *(const u32x2*)(ST + ((size_t)((b * 64 + c0 + k) * 16 + hh)) * 8192 + pn * 4); d[k] = DEC[(b * 64 + c0 + k) * 16 + hh]; }
#pragma unroll
            for (int k = 0; k < 8; ++k) {
                u32x2 o; o.x = pk2(run[0], run[1]); o.y = pk2(run[2], run[3]);
                if (!dry) *(u32x2*)(ST + ((size_t)((b * 64 + c0 + k) * 16 + hh)) * 8192 + pn * 4) = o;
                run[0] = run[0] * d[k] + bflo(s[k].x); run[1] = run[1] * d[k] + bfhi(s[k].x); run[2] = run[2] * d[k] + bflo(s[k].y); run[3] = run[3] * d[k] + bfhi(s[k].y);
            }
        }
    }
}

constexpr int S3_CT = 0, S3_BT = 34816, S3_Y = 69632, S3_ACS = S3_Y + 8 * 8320, S3_SSQ = S3_ACS + 8 * 1024;
__device__ __forceinline__ void phase_s3(const Frame& F, const Params& P, int layer, const bool dry) {
    unsigned char* ws = (unsigned char*)F.ws;
    const bf16* XT = (const bf16*)(ws + WS_XT); const bf16* BM = (const bf16*)(ws + WS_BM); const bf16* CM = (const bf16*)(ws + WS_CM);
    const float* DTV = (const float*)(ws + WS_DTV); const bf16* ST = (const bf16*)(ws + WS_STATES);
    bf16* YC = (bf16*)(ws + WS_YC); unsigned char* YC8 = ws + WS_YC8;
    const float* alog = P.in[22] + layer * 16; const float* dsk = P.in[23] + layer * 16; const float* ng = P.in[24] + (size_t)layer * 1024;
    LAS unsigned char* Ct = F.lds + S3_CT; LAS unsigned char* Bt = F.lds + S3_BT;
    LAS float* Y = (LAS float*)(F.lds + S3_Y + F.wave * 8320);
    LAS float* acs = (LAS float*)(F.lds + S3_ACS) + F.wave * 256; LAS float* dts = acs + 128;
    LAS float* ssq = (LAS float*)(F.lds + S3_SSQ);
    const int lane = F.lane, hi = lane >> 5, l31 = lane & 31;
    for (int u = F.vcu; u < NB * 64 * 2; u += F.G) {
        const int g = u & 1, c = (u >> 1) & 63, b = u >> 7, hh = g * 8 + F.wave, t0 = c * 128;
#pragma unroll
        for (int k = 0; k < 4; ++k) { const int idx = F.tid + k * NTHREADS, r = idx >> 4, ch = idx & 15;
            const u32x4 vc = *(const u32x4*)(CM + (size_t)(b * SEQ + t0 + r) * 256 + g * 128 + ch * 8);
            const u32x4 vb = *(const u32x4*)(BM + (size_t)(b * SEQ + t0 + r) * 256 + g * 128 + ch * 8);
            *(LAS u32x4*)(Ct + r * 272 + ch * 16) = vc; *(LAS u32x4*)(Bt + r * 272 + ch * 16) = vb; }
        const float A = -__expf(alog[hh]);
        (void)ssd_chunk_scan(DTV, b, t0, hh, A, lane, acs, dts);
        const float Dh = dsk[hh];
        __syncthreads();
        const bf16* sin = ST + ((size_t)((b * 64 + c) * 16 + hh)) * 8192;
        bf16x8 sfr[2][8];
#pragma unroll
        for (int pt = 0; pt < 2; ++pt)
#pragma unroll
            for (int ks = 0; ks < 8; ++ks) sfr[pt][ks] = ld8(sin + (pt * 32 + l31) * 128 + 16 * ks + 8 * hi);
        for (int lt = 0; lt < 4; ++lt) {
            f32x16 acc[2] = {zero16(), zero16()};
            const int lcol = 32 * lt + l31;
#pragma unroll
            for (int ks = 0; ks < 8; ++ks) {
                const bf16x8 cf = lds8(Ct + lcol * 272 + (16 * ks + 8 * hi) * 2);
#pragma unroll
                for (int pt = 0; pt < 2; ++pt) acc[pt] = MFMA32(sfr[pt][ks], cf, acc[pt]);
            }
            const float acl = acs[lcol], el = __expf(acl);
#pragma unroll
            for (int pt = 0; pt < 2; ++pt)
#pragma unroll
                for (int i = 0; i < 16; ++i) acc[pt][i] *= el;
            for (int st = 0; st <= lt; ++st) {
                f32x16 cb = zero16();
#pragma unroll
                for (int ks = 0; ks < 8; ++ks) {
                    const bf16x8 bfm = lds8(Bt + (32 * st + l31) * 272 + (16 * ks + 8 * hi) * 2);
                    const bf16x8 cf = lds8(Ct + lcol * 272 + (16 * ks + 8 * hi) * 2);
                    cb = MFMA32(bfm, cf, cb);
                }
                float mv[16];
#pragma unroll
                for (int q = 0; q < 4; ++q) {
                    const int s0 = 32 * st + 8 * q + 4 * hi;
                    const f32x4 as4 = *(const LAS f32x4*)(acs + s0), dt4 = *(const LAS f32x4*)(dts + s0);
#pragma unroll
                    for (int e = 0; e < 4; ++e) { const int s = s0 + e; float v = 0.f;
                        if (s <= lcol) v = cb[4 * q + e] * __expf(acl - as4[e]) * dt4[e];
                        if (s == lcol) v += Dh;
                        mv[4 * q + e] = v; }
                }
#pragma unroll
                for (int k2 = 0; k2 < 2; ++k2) {
                    u32x4 pw; pw.x = pk2(mv[8 * k2 + 0], mv[8 * k2 + 1]); pw.y = pk2(mv[8 * k2 + 2], mv[8 * k2 + 3]);
                    pw.z = pk2(mv[8 * k2 + 4], mv[8 * k2 + 5]); pw.w = pk2(mv[8 * k2 + 6], mv[8 * k2 + 7]);
                    const bf16x8 pf = __builtin_bit_cast(bf16x8, pw);
#pragma unroll
                    for (int pt = 0; pt < 2; ++pt) {
                        const bf16* xp = XT + ((size_t)b * 1024 + hh * 64 + pt * 32 + l31) * SEQ + t0 + 32 * st + 16 * k2 + 4 * hi;
                        const u32x2 x0 = *(const u32x2*)xp, x1 = *(const u32x2*)(xp + 8);
                        u32x4 xa; xa.x = x0.x; xa.y = x0.y; xa.z = x1.x; xa.w = x1.y;
                        acc[pt] = MFMA32(__builtin_bit_cast(bf16x8, xa), pf, acc[pt]);
                    }
                }
            }
#pragma unroll
            for (int pt = 0; pt < 2; ++pt)
#pragma unroll
                for (int i = 0; i < 16; ++i) Y[l31 * 65 + pt * 32 + crow(i, hi)] = acc[pt][i];
            LDS_FENCE();
            const int tl = lane >> 1, ph = lane & 1, t = t0 + 32 * lt + tl;
            bf16* zp = YC + (size_t)(b * SEQ + t) * 1024 + hh * 64 + ph * 32;
            float v[32]; float sq = 0.f;
#pragma unroll
            for (int k = 0; k < 4; ++k) { const u32x4 zr = *(const u32x4*)(zp + k * 8);
                const unsigned zz[4] = {zr.x, zr.y, zr.z, zr.w};
#pragma unroll
                for (int e = 0; e < 4; ++e) { const float z0 = bflo(zz[e]), z1 = bfhi(zz[e]);
                    const float y0 = Y[tl * 65 + ph * 32 + k * 8 + 2 * e], y1 = Y[tl * 65 + ph * 32 + k * 8 + 2 * e + 1];
                    const float a0 = y0 * z0 * sigmoidf_(z0), a1 = y1 * z1 * sigmoidf_(z1);
                    v[k * 8 + 2 * e] = a0; v[k * 8 + 2 * e + 1] = a1; sq += a0 * a0 + a1 * a1; } }
            sq += __shfl_xor(sq, 1);
            if (ph == 0) ssq[F.wave * 32 + tl] = sq;
            __syncthreads();
            float tot = 0.f;
#pragma unroll
            for (int w = 0; w < 8; ++w) tot += ssq[w * 32 + tl];
            const float rs = frsq(tot * (1.0f / 512.0f) + EPS);
            const float* gp = ng + hh * 64 + ph * 32;
#pragma unroll
            for (int k2 = 0; k2 < 2; ++k2) { unsigned ow[4];
#pragma unroll
                for (int kk = 0; kk < 2; ++kk) { const int k = 2 * k2 + kk; const f32x4 g0 = *(const f32x4*)(gp + k * 8), g1 = *(const f32x4*)(gp + k * 8 + 4);
                    ow[2 * kk] = pk4_fp8(v[k * 8 + 0] * rs * g0.x, v[k * 8 + 1] * rs * g0.y, v[k * 8 + 2] * rs * g0.z, v[k * 8 + 3] * rs * g0.w);
                    ow[2 * kk + 1] = pk4_fp8(v[k * 8 + 4] * rs * g1.x, v[k * 8 + 5] * rs * g1.y, v[k * 8 + 6] * rs * g1.z, v[k * 8 + 7] * rs * g1.w); }
                u32x4 o; o.x = ow[0]; o.y = ow[1]; o.z = ow[2]; o.w = ow[3];
                if (!dry) *(u32x4*)(YC8 + (size_t)(b * SEQ + t) * 1024 + hh * 64 + ph * 32 + k2 * 16) = o; }
            __syncthreads();
        }
    }
}

template <int PASS>
__device__ __forceinline__ void phase_lru(const Frame& F, const Params& P, int layer, const bool dry) {
    unsigned char* ws = (unsigned char*)F.ws;
    const bf16* LX = (const bf16*)(ws + WS_LX); bf16* LG = (bf16*)(ws + WS_LG);
    float* AGG = (float*)(ws + WS_AGG); const float* CARRY = (const float*)(ws + WS_CARRY);
    const bf16* WRT = (const bf16*)(ws + WS_WRT); const bf16* WIT = (const bf16*)(ws + WS_WIT);
    const float* cw = P.in[12] + (size_t)layer * 4 * 1024; const float* cb = P.in[13] + (size_t)layer * 1024;
    const float* br = P.in[15] + (size_t)layer * 1024; const float* bi = P.in[17] + (size_t)layer * 1024; const float* lam = P.in[18] + (size_t)layer * 1024;
    const int* pos = (const int*)P.in[1];
    LAS unsigned char* xc = F.lds + F.wave * 18432;
    LAS unsigned char* lgt = xc + 9216;
    const int lane = F.lane, hi = lane >> 5, l31 = lane & 31;
    for (int u = F.vcu; u < NB * 128; u += F.G) {
        const int b = u >> 7, tc = u & 127, t0 = tc * 64;
        const u64 rmask = __ballot(pos[b * SEQ + t0 + lane] == 0);
        for (int hsel = 0; hsel < 2; ++hsel) {
            const int hd = F.wave * 2 + hsel;
            {
                const int cg = lane & 7, ch = hd * 64 + cg * 8;
                float wv[4][8], bv8[8];
                { const f32x4 b0 = *(const f32x4*)(cb + ch), b1 = *(const f32x4*)(cb + ch + 4);
                  bv8[0] = b0.x; bv8[1] = b0.y; bv8[2] = b0.z; bv8[3] = b0.w; bv8[4] = b1.x; bv8[5] = b1.y; bv8[6] = b1.z; bv8[7] = b1.w; }
#pragma unroll
                for (int k = 0; k < 4; ++k) { const f32x4 w0 = *(const f32x4*)(cw + k * 1024 + ch), w1 = *(const f32x4*)(cw + k * 1024 + ch + 4);
                    wv[k][0] = w0.x; wv[k][1] = w0.y; wv[k][2] = w0.z; wv[k][3] = w0.w; wv[k][4] = w1.x; wv[k][5] = w1.y; wv[k][6] = w1.z; wv[k][7] = w1.w; }
                const int tb = t0 + (lane >> 3) * 8;
                u32x4 xr[11], gr[8];
#pragma unroll
                for (int k = 0; k < 11; ++k) { const int ts = tb - 3 + k; const u32x4 v = *(const u32x4*)(LX + (size_t)(b * SEQ + (ts < 0 ? 0 : ts)) * 1024 + ch);
                    xr[k] = (ts >= 0) ? v : (u32x4){0u, 0u, 0u, 0u}; }
                if (PASS == 3) {
#pragma unroll
                    for (int it = 0; it < 8; ++it) gr[it] = *(const u32x4*)(LG + (size_t)(b * SEQ + tb + it) * 1024 + ch); }
#pragma unroll
                for (int it = 0; it < 8; ++it) {
                    const int tl = (lane >> 3) * 8 + it;
                    float o[8];
#pragma unroll
                    for (int e = 0; e < 8; ++e) o[e] = bv8[e];
#pragma unroll
                    for (int k = 0; k < 4; ++k) { const u32x4 x = xr[it + k];
                        o[0] += bflo(x.x) * wv[k][0]; o[1] += bfhi(x.x) * wv[k][1]; o[2] += bflo(x.y) * wv[k][2]; o[3] += bfhi(x.y) * wv[k][3];
                        o[4] += bflo(x.z) * wv[k][4]; o[5] += bfhi(x.z) * wv[k][5]; o[6] += bflo(x.w) * wv[k][6]; o[7] += bfhi(x.w) * wv[k][7]; }
                    u32x4 pw; pw.x = pk2(o[0], o[1]); pw.y = pk2(o[2], o[3]); pw.z = pk2(o[4], o[5]); pw.w = pk2(o[6], o[7]);
                    *(LAS u32x4*)(xc + tl * 144 + cg * 16) = pw;
                    if (PASS == 3) *(LAS u32x4*)(lgt + tl * 144 + cg * 16) = gr[it];
                }
            }
            LDS_FENCE();
            for (int jt = 0; jt < 2; ++jt) {
                f32x16 R[2] = {zero16(), zero16()}, I[2] = {zero16(), zero16()};
#pragma unroll
                for (int ks = 0; ks < 4; ++ks) {
                    const bf16x8 wr = ld8(WRT + (size_t)hd * 4096 + (jt * 32 + l31) * 64 + 16 * ks + 8 * hi);
                    const bf16x8 wi = ld8(WIT + (size_t)hd * 4096 + (jt * 32 + l31) * 64 + 16 * ks + 8 * hi);
#pragma unroll
                    for (int tt = 0; tt < 2; ++tt) { const bf16x8 af = lds8(xc + (tt * 32 + l31) * 144 + (16 * ks + 8 * hi) * 2);
                        R[tt] = MFMA32(af, wr, R[tt]); I[tt] = MFMA32(af, wi, I[tt]); }
                }
                const int j = jt * 32 + l31, ch = hd * 64 + j;
                const float cprev = (PASS == 3) ? CARRY[((size_t)b * 128 + tc) * 1024 + ch] : 0.f;
                const float brj = br[ch], bij = bi[ch], sp = softplusf_(-lam[ch]);
                float av[2][16], bv[2][16], Pm[8], Lm[8];
#pragma unroll
                for (int tt = 0; tt < 2; ++tt)
#pragma unroll
                    for (int q = 0; q < 4; ++q) {
                        float pp = 1.f, ll = 0.f;
#pragma unroll
                        for (int e = 0; e < 4; ++e) { const int i = 4 * q + e, tl = 32 * tt + 8 * q + 4 * hi + e, t = t0 + tl;
                            const float r = sigmoidf_(R[tt][i] + brj), ig = sigmoidf_(I[tt][i] + bij);
                            const float la = -8.0f * r * sp;
                            const bool rs = (rmask >> tl) & 1ull;
                            const float a = rs ? 0.f : __expf(la);
                            const float mult = rs ? 1.f : __builtin_amdgcn_sqrtf(fmaxf(0.f, __builtin_fmaf(-a, a, 1.f)));
                            const float xv = bf1(*(const LAS bf16*)(xc + tl * 144 + j * 2));
                            const float bb = mult * ig * xv;
                            av[tt][i] = a; bv[tt][i] = bb; pp *= a; ll = a * ll + bb; }
                        Pm[tt * 4 + q] = pp; Lm[tt * 4 + q] = ll;
                    }
                float Pp[8], Lp[8];
#pragma unroll
                for (int k = 0; k < 8; ++k) { Pp[k] = __shfl_xor(Pm[k], 32); Lp[k] = __shfl_xor(Lm[k], 32); }
                float cin[8];
                float c = cprev, ptot = 1.f;
#pragma unroll
                for (int k = 0; k < 16; ++k) { const int gq = k >> 1; const bool mine = ((k & 1) == hi);
                    const float pk = mine ? Pm[gq] : Pp[gq], lk = mine ? Lm[gq] : Lp[gq];
                    if (mine) cin[gq] = c;
                    c = pk * c + lk; ptot *= pk; }
                if (PASS == 1) {
                    if (hi == 0) { float* ap = AGG + (((size_t)b * 128 + tc) * 1024 + ch) * 2; ap[0] = ptot; ap[1] = c; }
                } else {
#pragma unroll
                    for (int tt = 0; tt < 2; ++tt)
#pragma unroll
                        for (int q = 0; q < 4; ++q) { float h = cin[tt * 4 + q];
#pragma unroll
                            for (int e = 0; e < 4; ++e) { const int i = 4 * q + e, tl = 32 * tt + 8 * q + 4 * hi + e;
                                h = av[tt][i] * h + bv[tt][i];
                                LAS bf16* gp = (LAS bf16*)(lgt + tl * 144 + j * 2);
                                *gp = f2bf(h * gelu_tanh(bf1(*gp))); } }
                }
            }
            LDS_FENCE();
            if (PASS == 3 && !dry) {
                const int cg = lane & 7, ch = hd * 64 + cg * 8;
#pragma unroll 4
                for (int it = 0; it < 8; ++it) { const int tl = it * 8 + (lane >> 3);
                    const u32x4 yv = *(const LAS u32x4*)(lgt + tl * 144 + cg * 16);
                    u32x2 o; o.x = pk4_fp8(bflo(yv.x), bfhi(yv.x), bflo(yv.y), bfhi(yv.y)); o.y = pk4_fp8(bflo(yv.z), bfhi(yv.z), bflo(yv.w), bfhi(yv.w));
                    *(u32x2*)(ws + WS_YB8 + (size_t)(b * SEQ + t0 + tl) * 1024 + ch) = o; }
            }
            LDS_FENCE();
        }
    }
}
__device__ __forceinline__ void phase_lru2(const Frame& F) {
    const float* AGG = (const float*)((unsigned char*)F.ws + WS_AGG); float* CARRY = (float*)((unsigned char*)F.ws + WS_CARRY);
    if (F.wave != 0) return;
    for (int u = F.vcu; u < 64; u += F.G) {
        const int b = u >> 4, ch = (u & 15) * 64 + F.lane;
        float h = 0.f;
        for (int c0 = 0; c0 < 128; c0 += 16) {
            float2 pl[16];
#pragma unroll
            for (int k = 0; k < 16; ++k) pl[k] = *(const float2*)(AGG + (((size_t)b * 128 + c0 + k) * 1024 + ch) * 2);
#pragma unroll
            for (int k = 0; k < 16; ++k) { CARRY[((size_t)b * 128 + c0 + k) * 1024 + ch] = h; h = pl[k].x * h + pl[k].y; }
        }
    }
}

#define DPPF(v, ctrl) __builtin_bit_cast(float, __builtin_amdgcn_update_dpp(0, __builtin_bit_cast(int, (v)), (ctrl), 0xf, 0xf, true))
constexpr float QSCALE = 0.125f * 1.4426950408889634f;
__device__ __forceinline__ void phase_n0(const Frame& F, const Params& P, int layer, const bool dry) {
    unsigned char* ws = (unsigned char*)F.ws;
    bf16* Q = (bf16*)(ws + WS_Q); const bf16* KV = (const bf16*)(ws + WS_KV);
    bf16* KC = (bf16*)(ws + WS_KC); bf16* KS = (bf16*)(ws + WS_KS); bf16* KW = (bf16*)(ws + WS_KW);
    bf16* VST = (bf16*)(ws + WS_VST); bf16* VWT = (bf16*)(ws + WS_VWT);
    const float* qg = P.in[4] + layer * 64; const float* kg = P.in[5] + layer * 64;
    const int* pos = (const int*)P.in[1];
    const int lane = F.lane;
    LAS bf16* tile = (LAS bf16*)F.lds;
    LAS float* sct = (LAS float*)(F.lds + 40960);
    const int p4 = lane & 3;
    float qg1[8], qg2[8], kg1[8], kg2[8];
#pragma unroll
    for (int e = 0; e < 8; ++e) { qg1[e] = qg[8 * p4 + e]; qg2[e] = qg[32 + 8 * p4 + e]; kg1[e] = kg[8 * p4 + e]; kg2[e] = kg[32 + 8 * p4 + e]; }
    for (int u = F.vcu; u < NB * 128; u += F.G) {
        const int b = u >> 7, tt = u & 127;
#pragma unroll
        for (int k = 0; k < 4; ++k) { const int e = F.tid + k * NTHREADS, tl = e >> 5, i = e & 31;
            const float inv = exp2f(-(float)i * (13.287712379549449f / 32.0f));
            const float ang = (float)pos[(size_t)b * SEQ + tt * 64 + tl] * inv;
            const double r = (double)ang - 6.283185307179586 * rint((double)ang * 0.15915494309189535);
            float sn, cs; __sincosf((float)r, &sn, &cs);
            sct[2 * e] = cs; sct[2 * e + 1] = sn; }
        __syncthreads();
#define N0_ROPE(xa, xc, g1, g2, osc, tl_, oa, oc) do { \
            float x1[8] = {bflo(xa.x), bfhi(xa.x), bflo(xa.y), bfhi(xa.y), bflo(xa.z), bfhi(xa.z), bflo(xa.w), bfhi(xa.w)}; \
            float x2[8] = {bflo(xc.x), bfhi(xc.x), bflo(xc.y), bfhi(xc.y), bflo(xc.z), bfhi(xc.z), bflo(xc.w), bfhi(xc.w)}; \
            float ss = 0.f; _Pragma("unroll") for (int e = 0; e < 8; ++e) ss += x1[e] * x1[e] + x2[e] * x2[e]; \
            ss += DPPF(ss, 0xB1); ss += DPPF(ss, 0x4E); \
            const float rs = frsq(ss * (1.0f / 64.0f) + EPS) ; \
            float o1[8], o2[8]; \
            _Pragma("unroll") for (int e2 = 0; e2 < 4; ++e2) { const f32x4 cq = *(const LAS f32x4*)(sct + ((tl_) * 32 + 8 * p4 + 2 * e2) * 2); \
                { const float y1 = x1[2 * e2] * rs * g1[2 * e2], y2 = x2[2 * e2] * rs * g2[2 * e2]; o1[2 * e2] = (y1 * cq.x - y2 * cq.y) * (osc); o2[2 * e2] = (y2 * cq.x + y1 * cq.y) * (osc); } \
                { const float y1 = x1[2 * e2 + 1] * rs * g1[2 * e2 + 1], y2 = x2[2 * e2 + 1] * rs * g2[2 * e2 + 1]; o1[2 * e2 + 1] = (y1 * cq.z - y2 * cq.w) * (osc); o2[2 * e2 + 1] = (y2 * cq.z + y1 * cq.w) * (osc); } } \
            oa.x = pk2(o1[0], o1[1]); oa.y = pk2(o1[2], o1[3]); oa.z = pk2(o1[4], o1[5]); oa.w = pk2(o1[6], o1[7]); \
            oc.x = pk2(o2[0], o2[1]); oc.y = pk2(o2[2], o2[3]); oc.z = pk2(o2[4], o2[5]); oc.w = pk2(o2[6], o2[7]); } while (0)
        { const int hd = lane >> 2;
#pragma unroll 1
          for (int k0 = 0; k0 < 8; k0 += 4) {
              u32x4 xa[4], xc[4];
#pragma unroll
              for (int k = 0; k < 4; ++k) { const bf16* src = Q + ((size_t)b * SEQ + tt * 64 + F.wave * 8 + k0 + k) * 1024 + hd * 64 + 8 * p4; xa[k] = *(const u32x4*)src; xc[k] = *(const u32x4*)(src + 32); }
#pragma unroll
              for (int k = 0; k < 4; ++k) { const int tl_ = F.wave * 8 + k0 + k; u32x4 oa, oc;
                  N0_ROPE(xa[k], xc[k], qg1, qg2, QSCALE, tl_, oa, oc);
                  bf16* dst = Q + ((size_t)b * SEQ + tt * 64 + tl_) * 1024 + hd * 64 + 8 * p4;
                  if (!dry) { *(u32x4*)dst = oa; *(u32x4*)(dst + 32) = oc; } } } }
        { const int tsub = lane >= 24 ? 1 : 0, r = lane - 24 * tsub, kk = (r >> 2) % 6, which = kk >> 1, gk = kk & 1; const bool act = lane < 48;
          u32x4 xa[4], xc[4];
#pragma unroll
          for (int it = 0; it < 4; ++it) { const bf16* src = KV + ((size_t)b * SEQ + tt * 64 + F.wave * 8 + 2 * it + tsub) * 768 + which * 256 + gk * 64 + 8 * p4; xa[it] = *(const u32x4*)src; xc[it] = *(const u32x4*)(src + 32); }
#pragma unroll
          for (int it = 0; it < 4; ++it) { const int tl_ = F.wave * 8 + 2 * it + tsub; u32x4 oa, oc;
              N0_ROPE(xa[it], xc[it], kg1, kg2, 1.0f, tl_, oa, oc);
              bf16* dst = (which == 0 ? KC : (which == 1 ? KS : KW)) + ((size_t)b * SEQ + tt * 64 + tl_) * 128 + gk * 64 + 8 * p4;
              if (act) { *(u32x4*)dst = oa; *(u32x4*)(dst + 32) = oc; } } }
#undef N0_ROPE
        { const int tl = F.tid >> 3, cg = F.tid & 7; const size_t m = (size_t)b * SEQ + tt * 64 + tl;
#pragma unroll
          for (int w2 = 0; w2 < 2; ++w2)
#pragma unroll
            for (int ps = 0; ps < 2; ++ps) { const int col = (cg + 8 * ps) * 8;
                const u32x4 v = *(const u32x4*)(KV + m * 768 + (w2 == 0 ? 384 : 640) + col);
                const unsigned vv[4] = {v.x, v.y, v.z, v.w};
#pragma unroll
                for (int e = 0; e < 4; ++e) { const int ps_ = (((tl >> 3) ^ cg) << 3) | (tl & 7); tile[(w2 * 128 + col + 2 * e) * 64 + ps_] = (bf16)(vv[e] & 0xffffu); tile[(w2 * 128 + col + 2 * e + 1) * 64 + ps_] = (bf16)(vv[e] >> 16); } }
          __syncthreads();
#pragma unroll
          for (int k = 0; k < 4; ++k) { const int idx = F.tid + k * NTHREADS, row = idx >> 3, chk = idx & 7;
              const u32x4 v = *(const LAS u32x4*)(tile + row * 64 + ((chk ^ ((row >> 3) & 7)) << 3));
              bf16* dst = (row < 128 ? VST : VWT) + ((size_t)b * 128 + (row & 127)) * SEQ + tt * 64 + chk * 8;
              *(u32x4*)dst = v; }
          __syncthreads(); }
    }
}

constexpr int N1_PE = 0, N1_H = 8192, N1_O = 8192 + 32 * 264 * 2;
__device__ __forceinline__ void phase_n1(const Frame& F, const Params& P, int layer) {
    unsigned char* ws = (unsigned char*)F.ws;
    const bf16* KC = (const bf16*)(ws + WS_KC); const bf16* KV = (const bf16*)(ws + WS_KV);
    bf16* KCMP = (bf16*)(ws + WS_KCMP); bf16* VCMPT = (bf16*)(ws + WS_VCMPT);
    const float* kg = P.in[5] + layer * 64;
    LAS float* pe = (LAS float*)(F.lds + N1_PE);
    LAS unsigned char* H = F.lds + N1_H;
    LAS float* O = (LAS float*)(F.lds + N1_O);
    const int lane = F.lane, hi = lane >> 5, l31 = lane & 31;
    for (int u = F.vcu; u < 256; u += F.G) {
        const int kind = u >> 7, b = (u >> 5) & 3, g = (u >> 4) & 1, ct = u & 15;
        const float* pes = (kind == 0 ? P.in[6] : P.in[7]) + (size_t)layer * 2048;
        for (int e = F.tid; e < 2048; e += NTHREADS) pe[e] = pes[e];
        __syncthreads();
        const bf16* W1T = (const bf16*)(ws + (kind == 0 ? WS_W1K : WS_W1V));
        const bf16* W2T = (const bf16*)(ws + (kind == 0 ? WS_W2K : WS_W2V));
        const int c = 32 * ct + l31; const bool valid = c < 511; const int cc = valid ? c : 510;
        const bf16* abase = (kind == 0) ? (KC + ((size_t)b * SEQ + 16 * cc) * 128 + g * 64) : (KV + ((size_t)b * SEQ + 16 * cc) * 768 + 128 + g * 64);
        const int apitch = (kind == 0) ? 128 : 768;
        f32x16 acc = zero16();
#pragma unroll 8
        for (int ks = 0; ks < 128; ++ks) {
            const int l = ks >> 2, d0 = (ks & 3) * 16 + 8 * hi;
            const u32x4 xr = *(const u32x4*)(abase + (size_t)l * apitch + d0);
            const f32x4 p0 = *(const LAS f32x4*)(pe + l * 64 + d0), p1 = *(const LAS f32x4*)(pe + l * 64 + d0 + 4);
            u32x4 o; o.x = pk2(bflo(xr.x) + p0.x, bfhi(xr.x) + p0.y); o.y = pk2(bflo(xr.y) + p0.z, bfhi(xr.y) + p0.w);
            o.z = pk2(bflo(xr.z) + p1.x, bfhi(xr.z) + p1.y); o.w = pk2(bflo(xr.w) + p1.z, bfhi(xr.w) + p1.w);
            if (!valid) { o.x = 0u; o.y = 0u; o.z = 0u; o.w = 0u; }
            const bf16x8 bfr = ld8(W1T + (size_t)(F.wave * 32 + l31) * 2048 + 16 * ks + 8 * hi);
            acc = MFMA32(__builtin_bit_cast(bf16x8, o), bfr, acc);
        }
#pragma unroll
        for (int i = 0; i < 16; ++i) *(LAS bf16*)(H + crow(i, hi) * 528 + (F.wave * 32 + l31) * 2) = f2bf(gelu_tanh(acc[i]));
        __syncthreads();
        if (F.wave < 2) {
            f32x16 a2 = zero16();
#pragma unroll 4
            for (int ks = 0; ks < 16; ++ks) {
                const bf16x8 af = lds8(H + l31 * 528 + (16 * ks + 8 * hi) * 2);
                const bf16x8 bfr = ld8(W2T + (size_t)(F.wave * 32 + l31) * 256 + 16 * ks + 8 * hi);
                a2 = MFMA32(af, bfr, a2);
            }
#pragma unroll
            for (int i = 0; i < 16; ++i) O[crow(i, hi) * 65 + F.wave * 32 + l31] = a2[i];
        }
        __syncthreads();
#pragma unroll
        for (int rr = 0; rr < 4; ++rr) {
            const int r = F.wave * 4 + rr, cr = 32 * ct + r;
            float v = O[r * 65 + lane];
            if (kind == 0) { const float ss = wave_sum(v * v); v = v * frsq(ss * (1.0f / 64.0f) + EPS) * kg[lane];
                if (cr >= 511) v = 0.f;
                KCMP[((size_t)(b * 2 + g) * 512 + cr) * 64 + lane] = f2bf(v); }
            else { if (cr >= 511) v = 0.f; VCMPT[((size_t)(b * 2 + g) * 64 + lane) * 512 + cr] = f2bf(v); }
        }
        __syncthreads();
    }
}

constexpr int A_STG = 65536, A_IMP = 2 * A_STG, A_SELM = A_IMP + 8 * 4 * 132 * 4, A_UNI = A_SELM + 512, A_RDY = A_UNI + 16, A_DNE = A_RDY + 32, A_END = A_DNE + 256;
static_assert(A_END <= MISC_OFF, "N2 LDS map");
__device__ __forceinline__ void stage_issue(LAS unsigned char* lds, int buf, int wave, int lane, const bf16* kb, int kp, const bf16* vb, int vp) {
    asm volatile("" : "+v"(lane)); lane &= 63;
    const bf16* base = (wave & 1) ? vb : kb; const int pitch = (wave & 1) ? vp : kp;
    LAS unsigned char* dst = lds + buf * A_STG + (wave >> 1) * 16384 + (wave & 1) * 8192;
    const int r8 = lane >> 3, cb = (lane & 7) ^ (r8 >> 1);
    const bf16* p0 = base + (size_t)r8 * pitch + cb * 8; const bf16* p1 = base + (size_t)r8 * pitch + (cb ^ 4) * 8;
    const size_t step = (size_t)8 * pitch;
#pragma unroll
    for (int q = 0; q < 8; ++q) {
        __builtin_amdgcn_global_load_lds((const unsigned*)((q & 1) ? p1 : p0), (LAS unsigned*)(dst + q * 1024), 16, 0, 0);
        p0 += step; p1 += step; asm volatile("" : "+v"(p0), "+v"(p1)); }
}
#define DMA_WAIT() asm volatile("s_waitcnt vmcnt(0)" ::: "memory")
__device__ __forceinline__ void half_issue(LAS unsigned char* dst, int lane, const bf16* base, int pitch) {
    asm volatile("" : "+v"(lane)); lane &= 63;
    const int r8 = lane >> 3, cb = (lane & 7) ^ (r8 >> 1);
    const bf16* p0 = base + (size_t)r8 * pitch + cb * 8; const bf16* p1 = base + (size_t)r8 * pitch + (cb ^ 4) * 8;
    const size_t step = (size_t)8 * pitch;
#pragma unroll
    for (int q = 0; q < 8; ++q) {
        __builtin_amdgcn_global_load_lds((const unsigned*)((q & 1) ? p1 : p0), (LAS unsigned*)(dst + q * 1024), 16, 0, 0);
        p0 += step; p1 += step; asm volatile("" : "+v"(p0), "+v"(p1)); }
}
__device__ __forceinline__ unsigned flag_ld(const LAS unsigned* p) { asm volatile("" ::: "memory"); const unsigned v = *(const volatile LAS unsigned*)p; asm volatile("" ::: "memory"); return (unsigned)__builtin_amdgcn_readfirstlane((int)v); }
__device__ __forceinline__ void flag_st(LAS unsigned* p, unsigned v) { asm volatile("" ::: "memory"); *(volatile LAS unsigned*)p = v; asm volatile("" ::: "memory"); }
typedef float f32x4v __attribute__((ext_vector_type(4)));
#define MFMA16(a, b, c) __builtin_amdgcn_mfma_f32_16x16x32_bf16((a), (b), (c), 0, 0, 0)
template <int MODE, bool MASKED, int gm>
__device__ __forceinline__ void attn_tile(const unsigned akoff, const unsigned bvoff, const LAS unsigned char* Kb, const LAS unsigned char* Vb, const bf16x8 (&qf)[2][2], f32x4v (&oacc)[2][4], float (&lsum)[2], int lane,
                                           const int (&tq)[2], int kbase, const float (&off)[2], LAS float* impw) {
    asm volatile("" : "+v"(lane)); lane &= 63;
    const int kg = lane >> 4, r15 = lane & 15;
    const unsigned AK = (unsigned)(size_t)Kb + akoff, BV = (unsigned)(size_t)Vb + bvoff;
    f32x4v s[2][4];
#pragma unroll
    for (int g = 0; g < 2; ++g)
#pragma unroll
        for (int kt = 0; kt < 4; ++kt) { s[g][kt][0] = -off[g]; s[g][kt][1] = -off[g]; s[g][kt][2] = -off[g]; s[g][kt][3] = -off[g]; }
#pragma unroll
    for (int kt = 0; kt < 4; ++kt)
#pragma unroll
        for (int ks = 0; ks < 2; ++ks) { const bf16x8 kf = lds8((const LAS unsigned char*)(AK ^ (unsigned)(ks << 6)) + kt * 2048);
            if (gm & 1) s[0][kt] = MFMA16(kf, qf[0][ks], s[0][kt]);
            if (gm & 2) s[1][kt] = MFMA16(kf, qf[1][ks], s[1][kt]); }
    bf16x8 pf[2][2];
#pragma unroll
    for (int g = 0; g < 2; ++g) {
        if (!((gm >> g) & 1)) continue;
#pragma unroll
        for (int kt = 0; kt < 4; ++kt) {
            const int lim = tq[g] - kbase - 16 * kt - 4 * kg;
#pragma unroll
            for (int i = 0; i < 4; ++i) {
                float e = __builtin_amdgcn_exp2f(s[g][kt][i]);
                if (MASKED) { bool valid;
                    if (MODE <= 1) valid = (16 * i + 31 <= tq[g] - 16 * (kbase + 16 * kt + 4 * kg)); else if (MODE == 2) valid = (i <= lim); else valid = (i <= lim) && (i + 512 > lim);
                    e = valid ? e : 0.f; }
                s[g][kt][i] = e; lsum[g] += e;
            }
            if (MODE == 1) {
                float a = s[g][kt][0] + s[g][kt][1] + s[g][kt][2] + 0.5f * s[g][kt][3], bq = 0.5f * s[g][kt][3];
                a += DPPF(a, 0xB1); bq += DPPF(bq, 0xB1); a += DPPF(a, 0x4E); bq += DPPF(bq, 0x4E); a += DPPF(a, 0x141); bq += DPPF(bq, 0x141);
                if ((lane & 7) == 0) { const int j = (kbase >> 2) + 4 * kt + kg; LAS float* ip = impw + (2 * g + (r15 >> 3)) * 132 + j;
                    atomicAdd((float*)ip, a); atomicAdd((float*)(ip + 1), bq); }
            }
        }
        if (MODE != 0) {
#pragma unroll
            for (int kp = 0; kp < 2; ++kp) { u32x4 pw; pw.x = pk2(s[g][2 * kp][0], s[g][2 * kp][1]); pw.y = pk2(s[g][2 * kp][2], s[g][2 * kp][3]);
                pw.z = pk2(s[g][2 * kp + 1][0], s[g][2 * kp + 1][1]); pw.w = pk2(s[g][2 * kp + 1][2], s[g][2 * kp + 1][3]); pf[g][kp] = __builtin_bit_cast(bf16x8, pw); }
        }
    }
    if (MODE == 0) return;
#pragma unroll
    for (int dt = 0; dt < 4; ++dt)
#pragma unroll
        for (int kp = 0; kp < 2; ++kp) {
            const LAS unsigned char* vp0 = (const LAS unsigned char*)(BV ^ (unsigned)((4 * kp) << 4)) + dt * 2048;
            const LAS unsigned char* vp1 = (const LAS unsigned char*)(BV ^ (unsigned)((4 * kp + 2) << 4)) + dt * 2048;
            const u32x2 v0 = *(const LAS u32x2*)vp0, v1 = *(const LAS u32x2*)vp1;
            u32x4 va; va.x = v0.x; va.y = v0.y; va.z = v1.x; va.w = v1.y; const bf16x8 vf = __builtin_bit_cast(bf16x8, va);
            if (gm & 1) oacc[0][dt] = MFMA16(vf, pf[0][kp], oacc[0][dt]);
            if (gm & 2) oacc[1][dt] = MFMA16(vf, pf[1][kp], oacc[1][dt]);
        }
}
template <int MODE, int GM>
__device__ __forceinline__ void attn_tile_m(bool masked, const unsigned akoff, const unsigned bvoff, const LAS unsigned char* Kb, const LAS unsigned char* Vb, const bf16x8 (&qf)[2][2], f32x4v (&oacc)[2][4], float (&lsum)[2], int lane,
                                             const int (&tq)[2], int kbase, const float (&off)[2], LAS float* impw) {
    if (masked) attn_tile<MODE, true, GM>(akoff, bvoff, Kb, Vb, qf, oacc, lsum, lane, tq, kbase, off, impw); else attn_tile<MODE, false, GM>(akoff, bvoff, Kb, Vb, qf, oacc, lsum, lane, tq, kbase, off, impw);
}
#define OACC_ZERO(o) do { _Pragma("unroll") for (int g_ = 0; g_ < 2; ++g_) _Pragma("unroll") for (int d_ = 0; d_ < 4; ++d_) { o[g_][d_][0] = 0.f; o[g_][d_][1] = 0.f; o[g_][d_][2] = 0.f; o[g_][d_][3] = 0.f; } } while (0)

__device__ __forceinline__ void phase_n2(const Frame& F, const Params& P, int layer, const bool dry) {
    unsigned char* ws = (unsigned char*)F.ws;
    bf16* Q = (bf16*)(ws + WS_Q); const bf16* MISC = (const bf16*)(ws + WS_MISC);
    const bf16* KS = (const bf16*)(ws + WS_KS); const bf16* KW = (const bf16*)(ws + WS_KW);
    const bf16* VST = (const bf16*)(ws + WS_VST); const bf16* VWT = (const bf16*)(ws + WS_VWT);
    const bf16* KCMP = (const bf16*)(ws + WS_KCMP); const bf16* VCMPT = (const bf16*)(ws + WS_VCMPT);
    const float* qg = P.in[4] + layer * 64; const float* kg_ = P.in[5] + layer * 64;
    LAS unsigned char* lds = F.lds;
    const int lane = F.lane, tid = F.tid, wave = F.wave, kg = lane >> 4, r15 = lane & 15, qq = r15 >> 3, h = r15 & 7;
    float gqm, gkm;
    { float a = fabsf(qg[lane]), c = fabsf(kg_[lane]);
#pragma unroll
      for (int o = 1; o < 64; o <<= 1) { a = fmaxf(a, __shfl_xor(a, o)); c = fmaxf(c, __shfl_xor(c, o)); }
      gqm = a; gkm = c; }
    const float Mb2 = 8.0f * gqm * gkm * 1.4426950408889634f;
    LAS float* impw = (LAS float*)(lds + A_IMP) + wave * 4 * 132;
    LAS u64* selm = (LAS u64*)(lds + A_SELM); LAS u64* uni = (LAS u64*)(lds + A_UNI);
    const int wt = wave >> 1;
    const int ngrp = (F.G % 8 == 0) ? 8 : 1, per = F.G / ngrp, grp = F.vcu / per;
    for (int u = F.vcu % per; u < (8 / ngrp) * 256; u += per) {
        const int rnd = (u & 255) / per, pos_ = (u & 255) % per, qt = (256 % per == 0) ? 255 - (rnd * per + ((rnd & 1) ? (per - 1 - pos_) : pos_)) : 255 - (u & 255);
        const int bg = ngrp == 8 ? grp : (u >> 8), b = bg >> 1, g = bg & 1;
        const int t0 = 32 * qt;
        unsigned akoff, bvoff; { int l_ = lane; asm volatile("" : "+v"(l_)); l_ &= 63; const int kg_l = l_ >> 4, r_l = l_ & 15, sw_l = (r_l >> 1) & 7;
            akoff = (unsigned)(r_l * 128 + (((kg_l ^ sw_l) & 3) << 4) + ((sw_l & 4) << 4)); bvoff = (unsigned)(r_l * 128 + 8 * (kg_l & 1) + (((kg_l >> 1) ^ sw_l) << 4)); }
        const int tq[2] = {t0 + 4 * wave + qq, t0 + 4 * wave + 2 + qq};
        bf16x8 qf[2][2]; float gate[2][3];
#pragma unroll
        for (int gi = 0; gi < 2; ++gi) { const size_t mq = (size_t)b * SEQ + tq[gi];
#pragma unroll
            for (int ks = 0; ks < 2; ++ks) qf[gi][ks] = ld8(Q + mq * 1024 + (g * 8 + h) * 64 + 32 * ks + 8 * kg);
#pragma unroll
            for (int k = 0; k < 3; ++k) gate[gi][k] = sigmoidf_(bf1(MISC[mq * 256 + 16 + (g * 8 + h) * 3 + k])); }
        for (int e = lane; e < 4 * 132; e += 64) impw[e] = 0.f;
        if (tid < 2) uni[tid] = 0ull;
        if (tid < 72) ((LAS unsigned*)(lds + A_RDY))[tid] = 0u;
        f32x4v otot[2][4]; OACC_ZERO(otot);
        const float offb[2] = {Mb2, Mb2};
        const int ncmp = min((t0 >> 4) + 1, 511), nct = (ncmp + 63) >> 6;
        const bf16* kcb = KCMP + (size_t)(b * 2 + g) * 512 * 64; const bf16* vcb = VCMPT + (size_t)(b * 2 + g) * 64 * 512;
        __syncthreads();
        if (wt < nct) stage_issue(lds, 0, wave, lane, kcb + (size_t)wt * 64 * 64, 64, vcb + wt * 64, 512);
        if (wt + 4 < nct) stage_issue(lds, 1, wave, lane, kcb + (size_t)(wt + 4) * 64 * 64, 64, vcb + (wt + 4) * 64, 512);
        DMA_WAIT(); __syncthreads();
        {
            float l1[2] = {0.f, 0.f}; f32x4v oacc[2][4]; OACC_ZERO(oacc);
            for (int kt = 0; kt < nct; ++kt) { const LAS unsigned char* tb = lds + (kt >> 2) * A_STG + (kt & 3) * 16384;
                attn_tile_m<0, 3>(1024 * kt + 1039 > t0, akoff, bvoff, tb, tb + 8192, qf, oacc, l1, lane, tq, 64 * kt, offb, impw); }
            float off2[2];
#pragma unroll
            for (int gi = 0; gi < 2; ++gi) { float l = l1[gi]; l += __shfl_xor(l, 16); l += __shfl_xor(l, 32); off2[gi] = l > 0.f ? Mb2 + __log2f(l) : 1e30f; }
            float l2[2] = {0.f, 0.f};
            for (int kt = 0; kt < nct; ++kt) { const LAS unsigned char* tb = lds + (kt >> 2) * A_STG + (kt & 3) * 16384;
                attn_tile_m<1, 3>(1024 * kt + 1039 > t0, akoff, bvoff, tb, tb + 8192, qf, oacc, l2, lane, tq, 64 * kt, off2, impw); }
#pragma unroll
            for (int gi = 0; gi < 2; ++gi)
#pragma unroll
                for (int dt = 0; dt < 4; ++dt) otot[gi][dt] = oacc[gi][dt] * gate[gi][0];
        }
        LDS_FENCE();
        u64 wu0 = 0ull, wu1 = 0ull, gu0[2] = {0ull, 0ull}, gu1[2] = {0ull, 0ull};
        for (int q4 = 0; q4 < 4; ++q4) {
            const int tqq = t0 + 4 * wave + q4, cur = tqq >> 6;
            unsigned key[2];
#pragma unroll
            for (int k2 = 0; k2 < 2; ++k2) { const int j = lane + 64 * k2;
                const bool forced = (j == 0) || (j == cur) || (j == cur - 1);
                const unsigned ib = __builtin_bit_cast(unsigned, impw[q4 * 132 + j]);
                key[k2] = forced ? (0xFFFFFF80u | (unsigned)(127 - j)) : ((j <= cur) ? ((((ib >> 7) + 1u) << 7) | (unsigned)(127 - j)) : (unsigned)(127 - j)); }
            unsigned thr = 0u;
            for (int bit = 31; bit >= 0; --bit) {
                const unsigned cand = thr | (1u << bit);
                const int cnt = __popcll(__ballot(key[0] >= cand)) + __popcll(__ballot(key[1] >= cand));
                if (cnt >= 16) thr = cand;
            }
            const u64 m0 = __ballot(key[0] >= thr), m1 = __ballot(key[1] >= thr);
            wu0 |= m0; wu1 |= m1; gu0[q4 >> 1] |= m0; gu1[q4 >> 1] |= m1;
            if (lane == 0) { selm[(wave * 4 + q4) * 2] = m0; selm[(wave * 4 + q4) * 2 + 1] = m1; }
        }
        if (lane == 0) { atomicOr((u64*)&uni[0], wu0); atomicOr((u64*)&uni[1], wu1); }
        __syncthreads();
        u64 mq0[2], mq1[2];
#pragma unroll
        for (int gi = 0; gi < 2; ++gi) { mq0[gi] = selm[(wave * 4 + 2 * gi + qq) * 2]; mq1[gi] = selm[(wave * 4 + 2 * gi + qq) * 2 + 1]; }
        const int curb = t0 >> 6;
        u64 ul0 = uni[0], ul1 = uni[1];
        if (curb < 63) { ul0 &= ((2ull << curb) - 1ull); ul1 = 0ull; } else if (curb == 63) { ul1 = 0ull; } else { ul1 &= ((2ull << (curb - 64)) - 1ull); }
        {
            float ls[2] = {0.f, 0.f}; f32x4v oacc[2][4]; OACC_ZERO(oacc);
            const bf16* ksb = KS + (size_t)b * SEQ * 128 + g * 64; const bf16* vsb = VST + ((size_t)b * 128 + g * 64) * SEQ;
            LAS unsigned* rdy = (LAS unsigned*)(lds + A_RDY); LAS unsigned* dne = (LAS unsigned*)(lds + A_DNE);
            u64 c0 = ul0, c1 = ul1, a0 = ul0, a1 = ul1;
#define NEXT1(r0, r1, j_) do { j_ = -1; if (r0) { j_ = __builtin_ctzll(r0); r0 &= r0 - 1ull; } else if (r1) { j_ = 64 + __builtin_ctzll(r1); r1 &= r1 - 1ull; } } while (0)
#pragma unroll 1
            for (int p = 0; p < 4; ++p) { int j; NEXT1(a0, a1, j);
                if (j >= 0 && wave == p) { LAS unsigned char* sb = lds + p * 16384;
                    half_issue(sb, lane, ksb + (size_t)j * 64 * 128, 128); half_issue(sb + 8192, lane, vsb + j * 64, SEQ);
                    DMA_WAIT(); flag_st(rdy + p, 1u); } }
            int i = 0;
#pragma unroll 1
            for (;;) {
                int j; NEXT1(c0, c1, j); if (j < 0) break;
                int ja; NEXT1(a0, a1, ja);
                const int sa = (i + 4) & 7, ga = (i + 4) >> 3;
                bool pend = false;
                if (ja >= 0 && sa == wave) {
                    for (;;) { const unsigned v = *(const volatile LAS unsigned*)(dne + sa * 8 + (lane & 7)); if (__ballot(v >= (unsigned)ga) == ~0ull) break; __builtin_amdgcn_s_sleep(1); }
                    asm volatile("" ::: "memory");
                    LAS unsigned char* sb = lds + sa * 16384;
                    half_issue(sb, lane, ksb + (size_t)ja * 64 * 128, 128); half_issue(sb + 8192, lane, vsb + ja * 64, SEQ);
                    pend = true;
                }
                const int jj = j & 63, sl = i & 7;
                const int gm = (int)(((j < 64 ? gu0[0] : gu1[0]) >> jj) & 1ull) | ((int)(((j < 64 ? gu0[1] : gu1[1]) >> jj) & 1ull) << 1);
                if (gm) { float offs[2];
#pragma unroll
                    for (int gi = 0; gi < 2; ++gi) offs[gi] = (((j < 64 ? mq0[gi] : mq1[gi]) >> jj) & 1ull) ? Mb2 : 1e30f;
                    while (flag_ld(rdy + sl) < (unsigned)((i >> 3) + 1)) __builtin_amdgcn_s_sleep(1);
                    const LAS unsigned char* tb = lds + sl * 16384;
                    if (gm == 1) attn_tile_m<2, 1>(j == curb, akoff, bvoff, tb, tb + 8192, qf, oacc, ls, lane, tq, 64 * j, offs, impw);
                    else if (gm == 2) attn_tile_m<2, 2>(j == curb, akoff, bvoff, tb, tb + 8192, qf, oacc, ls, lane, tq, 64 * j, offs, impw);
                    else attn_tile_m<2, 3>(j == curb, akoff, bvoff, tb, tb + 8192, qf, oacc, ls, lane, tq, 64 * j, offs, impw); }
                if (pend) { DMA_WAIT(); flag_st(rdy + sa, (unsigned)(ga + 1)); }
                asm volatile("s_waitcnt lgkmcnt(0)" ::: "memory");
                flag_st(dne + sl * 8 + wave, (unsigned)((i >> 3) + 1));
                ++i;
            }
#undef NEXT1
            __syncthreads();
#pragma unroll
            for (int gi = 0; gi < 2; ++gi) { float l = ls[gi]; l += __shfl_xor(l, 16); l += __shfl_xor(l, 32); const float sc = l > 0.f ? gate[gi][1] * frcp(l) : 0.f;
#pragma unroll
                for (int dt = 0; dt < 4; ++dt) otot[gi][dt] += oacc[gi][dt] * sc; }
        }
        {
            float ls[2] = {0.f, 0.f}; f32x4v oacc[2][4]; OACC_ZERO(oacc);
            const bf16* kwb = KW + (size_t)b * SEQ * 128 + g * 64; const bf16* vwb = VWT + ((size_t)b * 128 + g * 64) * SEQ;
            const int kt0 = max(0, t0 - 511) >> 6, kt1 = t0 >> 6;
            if (kt0 + wt <= kt1) stage_issue(lds, 0, wave, lane, kwb + (size_t)(kt0 + wt) * 64 * 128, 128, vwb + (kt0 + wt) * 64, SEQ);
            DMA_WAIT(); __syncthreads();
            int bi = 0;
            for (int ks0 = kt0; ks0 <= kt1; ks0 += 4) {
                if (ks0 + 4 + wt <= kt1) stage_issue(lds, bi ^ 1, wave, lane, kwb + (size_t)(ks0 + 4 + wt) * 64 * 128, 128, vwb + (ks0 + 4 + wt) * 64, SEQ);
#pragma unroll
                for (int q = 0; q < 4; ++q) { const int kt = ks0 + q;
                    if (kt <= kt1) { const bool full = (64 * kt >= t0 + 31 - 511) && (64 * kt + 63 <= t0);
                        const LAS unsigned char* tb = lds + bi * A_STG + q * 16384;
                        attn_tile_m<3, 3>(!full, akoff, bvoff, tb, tb + 8192, qf, oacc, ls, lane, tq, 64 * kt, offb, impw); } }
                DMA_WAIT(); __syncthreads();
                bi ^= 1;
            }
#pragma unroll
            for (int gi = 0; gi < 2; ++gi) { float l = ls[gi]; l += __shfl_xor(l, 16); l += __shfl_xor(l, 32); const float sc = l > 0.f ? gate[gi][2] * frcp(l) : 0.f;
#pragma unroll
                for (int dt = 0; dt < 4; ++dt) otot[gi][dt] += oacc[gi][dt] * sc; }
        }
#pragma unroll
        for (int gi = 0; gi < 2; ++gi) { unsigned char* op = ws + WS_YA8 + ((size_t)b * SEQ + tq[gi]) * 1024 + (g * 8 + h) * 64 + 4 * kg;
#pragma unroll
            for (int dt = 0; dt < 4; ++dt) { const unsigned w = pk4_fp8(otot[gi][dt][0], otot[gi][dt][1], otot[gi][dt][2], otot[gi][dt][3]);
                if (!dry) *(unsigned*)(op + 16 * dt) = w; } }
    }
}

__device__ __forceinline__ float wave_max(float v) {
#pragma unroll
    for (int o = 1; o < 64; o <<= 1) v = fmaxf(v, __shfl_xor(v, o));
    return v;
}
__device__ __forceinline__ void quant_vals(const f32x4 (&v)[4], unsigned (&q)[4], float& scale) {
    float am = 0.f;
#pragma unroll
    for (int j = 0; j < 4; ++j) am = fmaxf(am, fmaxf(fmaxf(fabsf(v[j].x), fabsf(v[j].y)), fmaxf(fabsf(v[j].z), fabsf(v[j].w))));
    am = wave_max(am);
    const float inv = am > 0.f ? 448.0f * frcp(am) : 0.f; scale = am > 0.f ? am * (1.0f / 448.0f) : 0.f;
#pragma unroll
    for (int j = 0; j < 4; ++j) { int w = 0; w = __builtin_amdgcn_cvt_pk_fp8_f32(fminf(fmaxf(v[j].x * inv, -448.f), 448.f), fminf(fmaxf(v[j].y * inv, -448.f), 448.f), w, false);
        w = __builtin_amdgcn_cvt_pk_fp8_f32(fminf(fmaxf(v[j].z * inv, -448.f), 448.f), fminf(fmaxf(v[j].w * inv, -448.f), 448.f), w, true); q[j] = (unsigned)w; }
}
__device__ __forceinline__ void phase_r0(const Frame& F, const Params& P, int layer) {
    unsigned char* ws = (unsigned char*)F.ws;
    rms_rows<true>(F, P.out, P.in[27] + (size_t)layer * DM, (bf16*)(ws + WS_HN), ws + WS_HN8S, 8.0f);
    const float* us = P.in[30] + (size_t)layer * 16384 * 1024; const float* vs = P.in[31] + (size_t)layer * 16384 * 1024;
    unsigned* U8 = (unsigned*)(ws + WS_U8); unsigned* V8 = (unsigned*)(ws + WS_V8); float* SU = (float*)(ws + WS_SU); float* SV = (float*)(ws + WS_SV);
    const int lane = F.lane;
    for (int e = F.gw; e < 16384; e += F.NGW) {
        f32x4 uv[4], vv[4];
#pragma unroll
        for (int j = 0; j < 4; ++j) { uv[j] = ((const f32x4*)(us + (size_t)e * 1024) + lane)[64 * j]; vv[j] = ((const f32x4*)(vs + (size_t)e * 1024) + lane)[64 * j]; }
        unsigned q[4]; float sc;
        quant_vals(uv, q, sc);
#pragma unroll
        for (int j = 0; j < 4; ++j) U8[((size_t)(2 * j + (lane >> 5)) * 16384 + e) * 32 + (lane & 31)] = q[j];
        if (lane == 0) SU[e] = sc;
        quant_vals(vv, q, sc);
#pragma unroll
        for (int j = 0; j < 4; ++j) V8[((size_t)(2 * j + (lane >> 5)) * 16384 + e) * 32 + (lane & 31)] = q[j];
        if (lane == 0) SV[e] = sc;
    }
}

#define CE_DESC(a, b) do { const unsigned _mx = (a) > (b) ? (a) : (b), _mn = (a) > (b) ? (b) : (a); (a) = _mx; (b) = _mn; } while (0)
__device__ __forceinline__ void sort16_desc(unsigned (&v)[64], const int base) {
#pragma unroll
    for (int k = 2; k <= 16; k <<= 1)
#pragma unroll
        for (int j = k >> 1; j > 0; j >>= 1)
#pragma unroll
            for (int i = 0; i < 16; ++i) { const int l = i ^ j;
                if (l > i) { if ((i & k) == 0) CE_DESC(v[base + i], v[base + l]); else CE_DESC(v[base + l], v[base + i]); } }
}
__device__ __forceinline__ void merge16_top(unsigned (&v)[64], const int abase, const int bbase) {
#pragma unroll
    for (int i = 0; i < 16; ++i) { const unsigned x = v[abase + i], y = v[bbase + 15 - i]; v[abase + i] = x > y ? x : y; }
#pragma unroll
    for (int j = 8; j > 0; j >>= 1)
#pragma unroll
        for (int i = 0; i < 16; ++i) { const int l = i ^ j; if (l > i) CE_DESC(v[abase + i], v[abase + l]); }
}
__device__ __forceinline__ void top16_of_64(unsigned (&v)[64]) {
    sort16_desc(v, 0); sort16_desc(v, 16); sort16_desc(v, 32); sort16_desc(v, 48);
    merge16_top(v, 0, 16); merge16_top(v, 32, 48); merge16_top(v, 0, 32);
}
__device__ __forceinline__ unsigned f2sortable(float f) { const unsigned u = __builtin_bit_cast(unsigned, f); return (u & 0x80000000u) ? ~u : (u | 0x80000000u); }
__device__ __forceinline__ float sortable2f(unsigned s) { const unsigned u = (s & 0x80000000u) ? (s & 0x7fffffffu) : ~s; return __builtin_bit_cast(float, u); }

constexpr int R2_SK = 0, R2_IDX = 69632;
__device__ __forceinline__ void phase_r2(const Frame& F) {
    unsigned char* ws = (unsigned char*)F.ws;
    const bf16* PQ = (const bf16*)(ws + WS_PQ); const bf16* SK = (const bf16*)(ws + WS_SK);
    int* RIDX = (int*)(ws + WS_RIDX); float* RG = (float*)(ws + WS_RG);
    LAS unsigned char* sk = F.lds + R2_SK;
    LAS unsigned char* idxs = F.lds + R2_IDX + (F.wave * 64 + F.lane) * 32;
    const int lane = F.lane, hi = lane >> 5, l31 = lane & 31;
    const bool keep = (F.G % 8 == 0);
    int h_loaded = -1;
    for (int u = keep ? (F.vcu >> 3) : F.vcu; u < (keep ? 128 : 128 * 8); u += keep ? (F.G >> 3) : F.G) {
        const int h = keep ? (F.vcu & 7) : (u & 7), tt = keep ? u : (u >> 3);
        if (h != h_loaded) {
            __syncthreads();
#pragma unroll
            for (int k = 0; k < 8; ++k) { const int idx = F.tid + k * NTHREADS, row = idx >> 4, ch = idx & 15;
                *(LAS u32x4*)(sk + row * 272 + ch * 16) = *(const u32x4*)(SK + ((size_t)h * 256 + row) * 128 + ch * 8); }
            __syncthreads();
            h_loaded = h;
        }
        const int tok = tt * 256 + F.wave * 32 + l31;
        unsigned top[2][16];
#pragma unroll
        for (int x = 0; x < 2; ++x) {
            f32x16 acc[4] = {zero16(), zero16(), zero16(), zero16()};
#pragma unroll
            for (int ks = 0; ks < 8; ++ks) {
                const bf16x8 qfr = ld8(PQ + (size_t)tok * 2048 + h * 256 + x * 128 + 16 * ks + 8 * hi);
#pragma unroll
                for (int kt = 0; kt < 4; ++kt) { const bf16x8 kf = lds8(sk + (x * 128 + kt * 32 + l31) * 272 + (16 * ks + 8 * hi) * 2); acc[kt] = MFMA32(kf, qfr, acc[kt]); }
            }
            unsigned v[64];
#pragma unroll
            for (int kt = 0; kt < 4; ++kt)
#pragma unroll
                for (int i = 0; i < 16; ++i) { const int key = kt * 32 + crow(i, hi); v[kt * 16 + i] = (f2sortable(acc[kt][i]) & ~0x7Fu) | (unsigned)(127 - key); }
            top16_of_64(v);
#pragma unroll
            for (int i = 0; i < 16; ++i) top[x][i] = v[i];
        }
        unsigned mine[64];
#pragma unroll
        for (int i = 0; i < 16; ++i) {
            const unsigned send = hi ? top[0][i] : top[1][i];
            const unsigned got = __shfl_xor(send, 32);
            mine[i] = hi ? top[1][i] : top[0][i]; mine[16 + i] = got;
        }
        merge16_top(mine, 0, 16);
        unsigned L0[16], L1[16];
#pragma unroll
        for (int i = 0; i < 16; ++i) { const unsigned got = __shfl_xor(mine[i], 32); L0[i] = hi ? got : mine[i]; L1[i] = hi ? mine[i] : got; }
#pragma unroll
        for (int q = 0; q < 4; ++q) {
            unsigned w0 = 0u, w1 = 0u;
#pragma unroll
            for (int e = 0; e < 4; ++e) { w0 |= (127u - (L0[4 * q + e] & 0x7Fu)) << (8 * e); w1 |= (127u - (L1[4 * q + e] & 0x7Fu)) << (8 * e); }
            *(LAS unsigned*)(idxs + 4 * q) = w0; *(LAS unsigned*)(idxs + 16 + 4 * q) = w1;
        }
        float f0[16], f1[16];
#pragma unroll
        for (int i = 0; i < 16; ++i) { f0[i] = sortable2f(L0[i] & ~0x7Fu); f1[i] = sortable2f(L1[i] & ~0x7Fu); }
        unsigned cnd[64];
        {
            int slot = 0;
#pragma unroll
            for (int i = 0; i < 16; ++i)
#pragma unroll
                for (int j = 0; j < 16; ++j)
                    if ((i + 1) * (j + 1) <= 16) { cnd[slot] = (f2sortable(f0[i] + f1[j]) & ~0xFFu) | (unsigned)(255 - (i * 16 + j)); ++slot; }
#pragma unroll
            for (int s = 50; s < 64; ++s) cnd[s] = 0u;
        }
        top16_of_64(cnd);
        LDS_FENCE();
        float e[16], esum = 0.f; const float vmax = sortable2f(cnd[0] & ~0xFFu);
#pragma unroll
        for (int k = 0; k < 16; ++k) { e[k] = __expf(sortable2f(cnd[k] & ~0xFFu) - vmax); esum += e[k]; }
        const float rinv = 1.0f / esum;
        if (hi == 0) {
            int* ip = RIDX + ((size_t)tok * 8 + h) * 16; float* gp = RG + ((size_t)tok * 8 + h) * 16;
#pragma unroll
            for (int k = 0; k < 16; ++k) { const unsigned pay = 255u - (cnd[k] & 0xFFu); const int i = pay >> 4, j = pay & 15;
                const int i1 = *(const LAS unsigned char*)(idxs + i), i2 = *(const LAS unsigned char*)(idxs + 16 + j);
                ip[k] = i1 * 128 + i2; gp[k] = e[k] * rinv; }
        }
    }
}

#define dppf(v, ctrl) __builtin_bit_cast(float, __builtin_amdgcn_update_dpp(0, __builtin_bit_cast(int, (v)), (ctrl), 0xf, 0xf, true))
typedef float f32x2v __attribute__((ext_vector_type(2)));
typedef float f32x4w __attribute__((ext_vector_type(4)));
__device__ __forceinline__ void phase_r3a(const Frame& F) {
    unsigned char* ws = (unsigned char*)F.ws;
    const unsigned char* H8 = (const unsigned char*)(ws + WS_HN8S); const unsigned char* U8 = (const unsigned char*)(ws + WS_U8);
    const int* RIDX = (const int*)(ws + WS_RIDX); bf16* PWP = (bf16*)(ws + WS_PWP);
    const int lane = F.lane, g8 = lane >> 3, c8 = lane & 7, r15 = lane & 15, kg = lane >> 4;
    LAS unsigned char* stg = F.lds + F.wave * 4608;
    const int ngrp = (F.G % 8 == 0) ? 8 : 1, per = F.G / ngrp, grp = F.vcu / per, wx = (F.vcu % per) * NWAVES + F.wave, nwx = per * NWAVES;
    const __amdgpu_buffer_rsrc_t urs = __builtin_amdgcn_make_buffer_rsrc((void*)U8, 0, 16 * 1024 * 1024, 0x00020000);
#define R3A_IDX(tok) do { _Pragma("unroll") for (int i = 0; i < 16; ++i) idx[i] = RIDX[(size_t)(tok) * 128 + 8 * i + g8]; } while (0)
#define R3A_ROWS(UR, HV, tok) do { _Pragma("unroll") for (int i = 0; i < 16; ++i) UR[i] = __builtin_bit_cast(u32x4, __builtin_amdgcn_raw_buffer_load_b128(urs, idx[i] * 128 + c8 * 16, x * (16384 * 128), 0)); \
        const unsigned char* hp_ = H8 + (size_t)(tok) * 1024 + 128 * x + 32 * kg; HV[0] = *(const u32x4*)hp_; HV[1] = *(const u32x4*)(hp_ + 16); } while (0)
#define R3A_PROC(UR, HV, tok) do { \
        const long hb0_ = (long)(((unsigned long long)HV[0].y << 32) | HV[0].x), hb1_ = (long)(((unsigned long long)HV[0].w << 32) | HV[0].z), \
                   hb2_ = (long)(((unsigned long long)HV[1].y << 32) | HV[1].x), hb3_ = (long)(((unsigned long long)HV[1].w << 32) | HV[1].z); \
        _Pragma("unroll") for (int j = 0; j < 8; ++j) { \
            LAS unsigned char* sb = stg + (j & 1) * 2304; \
            *(LAS u32x4*)(sb + g8 * 144 + c8 * 16) = UR[2 * j]; *(LAS u32x4*)(sb + (8 + g8) * 144 + c8 * 16) = UR[2 * j + 1];        \
            const u32x4 q0 = *(const LAS u32x4*)(sb + r15 * 144 + 32 * kg), q1 = *(const LAS u32x4*)(sb + r15 * 144 + 32 * kg + 16); \
            f32x4w acc = {0.f, 0.f, 0.f, 0.f}; \
            acc = __builtin_amdgcn_mfma_f32_16x16x32_fp8_fp8((long)(((unsigned long long)q0.y << 32) | q0.x), hb0_, acc, 0, 0, 0); \
            acc = __builtin_amdgcn_mfma_f32_16x16x32_fp8_fp8((long)(((unsigned long long)q0.w << 32) | q0.z), hb1_, acc, 0, 0, 0); \
            acc = __builtin_amdgcn_mfma_f32_16x16x32_fp8_fp8((long)(((unsigned long long)q1.y << 32) | q1.x), hb2_, acc, 0, 0, 0); \
            acc = __builtin_amdgcn_mfma_f32_16x16x32_fp8_fp8((long)(((unsigned long long)q1.w << 32) | q1.z), hb3_, acc, 0, 0, 0); \
            if (r15 == 0) { u32x2 pw_; pw_.x = pk2(acc[0], acc[1]); pw_.y = pk2(acc[2], acc[3]); *(u32x2*)(PWP + ((size_t)x * MT + (tok)) * 128 + j * 16 + 4 * kg) = pw_; } } } while (0)
    for (int x = grp; x < 8; x += ngrp) {
        if (wx >= MT) continue;
        int idx[16]; u32x4 ur0[16], ur1[16], hv0[2], hv1[2];
        const int tlast = wx + ((MT - 1 - wx) / nwx) * nwx;
        R3A_IDX(wx); R3A_ROWS(ur0, hv0, wx);
        { const int t1 = min(wx + nwx, tlast); R3A_IDX(t1); R3A_ROWS(ur1, hv1, t1); }
        { const int t2 = min(wx + 2 * nwx, tlast); R3A_IDX(t2); }
#pragma unroll 1
        for (int t = wx; t < MT; t += 2 * nwx) {
            const int t2 = min(t + 2 * nwx, tlast), t3 = min(t + 3 * nwx, tlast), t4 = min(t + 4 * nwx, tlast);
            R3A_PROC(ur0, hv0, t);
            R3A_ROWS(ur0, hv0, t2); R3A_IDX(t3);
            if (t + nwx < MT) R3A_PROC(ur1, hv1, t + nwx);
            R3A_ROWS(ur1, hv1, t3); R3A_IDX(t4);
        }
    }
#undef R3A_IDX
#undef R3A_ROWS
#undef R3A_PROC
}
__device__ __forceinline__ void phase_r3f(const Frame& F) {
    unsigned char* ws = (unsigned char*)F.ws;
    const bf16* PWP = (const bf16*)(ws + WS_PWP); const int* RIDX = (const int*)(ws + WS_RIDX); const float* RG = (const float*)(ws + WS_RG);
    const float* SU = (const float*)(ws + WS_SU); const float* SV = (const float*)(ws + WS_SV); float* PW = (float*)(ws + WS_PW);
    const int gt = F.vcu * NTHREADS + F.tid, NGT = F.G * NTHREADS;
    u32x2 pvn[8]; u32x4 ivn; f32x4 gn;
#define R3F_LOAD(p_) do { _Pragma("unroll") for (int x = 0; x < 8; ++x) pvn[x] = *(const u32x2*)(PWP + ((size_t)x * MT * 128) + (size_t)(p_) * 4); \
        ivn = *(const u32x4*)(RIDX + (size_t)(p_) * 4); gn = *(const f32x4*)(RG + (size_t)(p_) * 4); } while (0)
    if (gt < MT * 128 / 4) R3F_LOAD(gt);
#pragma unroll 1
    for (int p4 = gt; p4 < MT * 128 / 4; p4 += NGT) {
        u32x2 pv[8];
#pragma unroll
        for (int x = 0; x < 8; ++x) pv[x] = pvn[x];
        const u32x4 iv = ivn; const f32x4 g = gn;
        const float su0 = SU[iv.x], su1 = SU[iv.y], su2 = SU[iv.z], su3 = SU[iv.w], sv0 = SV[iv.x], sv1 = SV[iv.y], sv2 = SV[iv.z], sv3 = SV[iv.w];
        { const int pn = (p4 + NGT < MT * 128 / 4) ? p4 + NGT : p4; R3F_LOAD(pn); }
        f32x4 s = {0.f, 0.f, 0.f, 0.f};
#pragma unroll
        for (int x = 0; x < 8; ++x) { s.x += bflo(pv[x].x); s.y += bfhi(pv[x].x); s.z += bflo(pv[x].y); s.w += bfhi(pv[x].y); }
        f32x4 o;
        s = s * 0.125f;
        o.x = gelu_tanh(s.x * su0) * g.x * sv0; o.y = gelu_tanh(s.y * su1) * g.y * sv1;
        o.z = gelu_tanh(s.z * su2) * g.z * sv2; o.w = gelu_tanh(s.w * su3) * g.w * sv3;
        *(f32x4*)(PW + (size_t)p4 * 4) = o;
    }
#undef R3F_LOAD
}
__device__ __forceinline__ void phase_r3b(const Frame& F, const Params& P, const bool dry) {
    unsigned char* ws = (unsigned char*)F.ws;
    const unsigned char* V8 = (const unsigned char*)(ws + WS_V8);
    const int* RIDX = (const int*)(ws + WS_RIDX); const float* PW = (const float*)(ws + WS_PW);
    float* X = P.out;
    const int lane = F.lane, g8 = lane >> 3, c8 = lane & 7;
    const int ngrp = (F.G % 8 == 0) ? 8 : 1, per = F.G / ngrp, grp = F.vcu / per, wx = (F.vcu % per) * NWAVES + F.wave, nwx = per * NWAVES;
    const __amdgpu_buffer_rsrc_t vrs = __builtin_amdgcn_make_buffer_rsrc((void*)V8, 0, 16 * 1024 * 1024, 0x00020000);
#define R3B_ROW(e) __builtin_bit_cast(u32x4, __builtin_amdgcn_raw_buffer_load_b128(vrs, (e) * 128 + c8 * 16, x * (16384 * 128), 0))
    const __amdgpu_buffer_rsrc_t irs = __builtin_amdgcn_make_buffer_rsrc((void*)RIDX, 0, MT * 128 * 4, 0x00020000), prs = __builtin_amdgcn_make_buffer_rsrc((void*)PW, 0, MT * 128 * 4, 0x00020000),
                                 xrs = __builtin_amdgcn_make_buffer_rsrc((void*)X, 0, MT * 1024 * 4, 0x00020000);
#define R3B_ACC(vrv, wbase) do { _Pragma("unroll") for (int i = 0; i < 8; ++i) { const unsigned ww[4] = {vrv[i].x, vrv[i].y, vrv[i].z, vrv[i].w}; \
        _Pragma("unroll") for (int q = 0; q < 4; ++q) { const f32x2v a = __builtin_amdgcn_cvt_pk_f32_fp8((int)ww[q], false), b = __builtin_amdgcn_cvt_pk_f32_fp8((int)ww[q], true); \
            acc[4 * q] += w[(wbase) + i] * a.x; acc[4 * q + 1] += w[(wbase) + i] * a.y; acc[4 * q + 2] += w[(wbase) + i] * b.x; acc[4 * q + 3] += w[(wbase) + i] * b.y; } } } while (0)
#define R3B_IDX8(tb_, so_, idv) do { _Pragma("unroll") for (int q = 0; q < 2; ++q) { const u32x4 iv = __builtin_bit_cast(u32x4, __builtin_amdgcn_raw_buffer_load_b128(irs, (tb_) + 16 * q, (so_), 0)); idv[4 * q] = (int)iv.x; idv[4 * q + 1] = (int)iv.y; idv[4 * q + 2] = (int)iv.z; idv[4 * q + 3] = (int)iv.w; } } while (0)
#define R3B_W8(tb_, so_, wv) do { _Pragma("unroll") for (int q = 0; q < 2; ++q) { const f32x4 wq = __builtin_bit_cast(f32x4, __builtin_amdgcn_raw_buffer_load_b128(prs, (tb_) + 16 * q, (so_), 0)); wv[4 * q] = wq.x; wv[4 * q + 1] = wq.y; wv[4 * q + 2] = wq.z; wv[4 * q + 3] = wq.w; } } while (0)
    for (int x = grp; x < 8; x += ngrp) {
        if (wx * 8 >= MT) continue;
        int ia[8], ib[8]; float w[16];
        { const int tb0 = min(wx * 8 + g8, MT - 1) * 512; R3B_IDX8(tb0, 0, ia); R3B_IDX8(tb0, 32, ib); { float* wlo = w; R3B_W8(tb0, 0, wlo); } { float* whi = w + 8; R3B_W8(tb0, 32, whi); } }
        u32x4 va[8], vb[8];
#pragma unroll
        for (int i = 0; i < 8; ++i) va[i] = R3B_ROW(ia[i]);
        float acc[16];
#pragma unroll
        for (int c = 0; c < 16; ++c) acc[c] = 0.f;
#pragma unroll 1
        for (int t0 = wx * 8; t0 < MT; t0 += nwx * 8) {
            const int t = min(t0 + g8, MT - 1); const bool tv = t0 + g8 < MT;
            const int t0n = (t0 + nwx * 8 < MT) ? t0 + nwx * 8 : t0, tnx = min(t0n + g8, MT - 1);
            const int tb = t * 512, tbn = tnx * 512, xo = t * 4096 + 512 * x + 64 * c8;
            f32x4 xv[4];
#pragma unroll 1
            for (int ch = 0; ch < 8; ++ch) {
                const int tkb = (ch < 7) ? tb : tbn, so = (ch < 7) ? 64 * (ch + 1) : 0;
#pragma unroll
                for (int i = 0; i < 8; ++i) vb[i] = R3B_ROW(ib[i]);
                R3B_IDX8(tkb, so, ia);
                if (ch == 7) {
#pragma unroll
                    for (int q = 0; q < 4; ++q) xv[q] = __builtin_bit_cast(f32x4, __builtin_amdgcn_raw_buffer_load_b128(xrs, xo + 16 * q, 0, 0)); }
                R3B_ACC(va, 0);
                { float* wlo = w; R3B_W8(tkb, so, wlo); }
#pragma unroll
                for (int i = 0; i < 8; ++i) va[i] = R3B_ROW(ia[i]);
                R3B_IDX8(tkb, so + 32, ib);
                R3B_ACC(vb, 8);
                { float* whi = w + 8; R3B_W8(tkb, so + 32, whi); }
            }
            if (tv && !dry) {
#pragma unroll
                for (int q = 0; q < 4; ++q) { f32x4 o = xv[q]; o.x += acc[4 * q]; o.y += acc[4 * q + 1]; o.z += acc[4 * q + 2]; o.w += acc[4 * q + 3];
                    int so_ = xo + 16 * q; asm volatile("" : "+v"(so_)); __builtin_amdgcn_raw_buffer_store_b128(__builtin_bit_cast(u32x4, o), xrs, so_, 0, 0); } }
#pragma unroll
            for (int c = 0; c < 16; ++c) acc[c] = 0.f;
        }
    }
#undef R3B_IDX8
#undef R3B_W8
#undef R3B_ACC
#undef R3B_ROW
}

#ifndef PHASE_MASK
#define PHASE_MASK 0x3FFFFu
#endif
#define IN(k) (((PHASE_MASK >> (((k)) % NPH)) & 1u) && lo <= (k) && (k) < hi)
#define INR(k) (lo <= (k) && (k) < hi)
#define SEAM(k) do { if (INR(k) && INR((k) + 1)) xcd_barrier(bar); } while (0)
__device__ __forceinline__ void layer_body(const Frame& F0, const Params& P, const XcdBarrier& bar, const int layer0, const int lo, const int hi) {
    const int pb = layer0 * NPH;
#define DRY false
#define PH_BEGIN const Frame F = launder(F0); const int layer = launder_i(layer0); unsigned char* ws = (unsigned char*)F.ws; (void)layer; (void)ws;
    if (IN(pb + 0)) { PH_BEGIN phase_prep(F, P, layer); } SEAM(pb + 0);
    if (IN(pb + 1)) { PH_BEGIN
        pg8::Gemm g{(const pg8::bf16_t*)(ws + WS_XN), (const pg8::bf16_t*)(ws + WS_WIN) + (size_t)WA_ROW0 * 1024, MT, WA_N + 256, 1024};
        pg8::StaticOrder S; S.init(MT, WA_N + 256, F.G, (int)blockIdx.x);
        EpiSeg E{{(bf16*)(ws + WS_YC), 1024, 4, (bf16*)(ws + WS_XBC), 1536, 10, (bf16*)(ws + WS_MISC), 256, 11, (bf16*)(ws + WS_LX), 1024}};
        pg8::gemm_phase<EpiSeg, pg8::StaticOrder, true, true>(F.lds, g, S, E);
    } SEAM(pb + 1);
    if (IN(pb + 2)) { PH_BEGIN phase_s0(F, P, layer); } SEAM(pb + 2);
    if (IN(pb + 3)) { PH_BEGIN phase_s1(F, P, layer); } SEAM(pb + 3);
    if (IN(pb + 4)) { PH_BEGIN phase_s2(F, DRY); } SEAM(pb + 4);
    if (IN(pb + 5)) { PH_BEGIN phase_s3(F, P, layer, DRY); } SEAM(pb + 5);
    if (IN(pb + 6)) { PH_BEGIN
        pg8::Gemm g{(const pg8::bf16_t*)(ws + WS_XN), (const pg8::bf16_t*)(ws + WS_WIN) + (size_t)(WB_ROW0 + 256) * 1024, MT, WB_N + WC_N - 256, 1024};
        pg8::StaticOrder S; S.init(MT, WB_N + WC_N - 256, F.G, (int)blockIdx.x);
        EpiSeg E{{(bf16*)(ws + WS_LX) + 256, 1024, 3, (bf16*)(ws + WS_LG), 1024, 7, (bf16*)(ws + WS_Q), 1024, 11, (bf16*)(ws + WS_KV), 768}};
        pg8::gemm_phase<EpiSeg, pg8::StaticOrder, true, true>(F.lds, g, S, E);
    } SEAM(pb + 6);
    if (IN(pb + 7)) { PH_BEGIN phase_lru<1>(F, P, layer, false); __syncthreads(); phase_n0(F, P, layer, DRY); } SEAM(pb + 7);
    if (IN(pb + 8)) { PH_BEGIN phase_lru2(F); __syncthreads(); phase_n1(F, P, layer); } SEAM(pb + 8);
    if (IN(pb + 9)) { PH_BEGIN phase_lru<3>(F, P, layer, DRY); __syncthreads(); phase_n2(F, P, layer, DRY); } SEAM(pb + 9);
    if (IN(pb + 10)) { PH_BEGIN
        pg8::Gemm g{(const pg8::bf16_t*)(ws + WS_YA8), (const pg8::bf16_t*)(ws + WS_WMRG), 4 * MT, 6144, 512};
        MergeOrder S{F.G, F.vcu};
        EpiMerge E{ws + WS_GBUF + (size_t)blockIdx.x * 131072, ws + WS_MBUF + (size_t)blockIdx.x * 131072, (bf16*)(ws + WS_MERGED)};
        pg8::gemm_phase<EpiMerge, MergeOrder, true, true, true>(F.lds, g, S, E);
    } SEAM(pb + 10);
    if (IN(pb + 11)) { PH_BEGIN
        const float* xin = layer == 0 ? P.in[0] : P.out;
        pg8::Gemm g{(const pg8::bf16_t*)(ws + WS_MERGED), (const pg8::bf16_t*)(ws + WS_WOUT), MT, 1024, 1024};
        pg8::StaticOrder S; S.init(MT, 1024, F.G, (int)blockIdx.x);
        EpiResid E{xin, P.out, DRY};
        pg8::gemm_phase<EpiResid, pg8::StaticOrder, true, true>(F.lds, g, S, E);
    } SEAM(pb + 11);
    if (IN(pb + 12)) { PH_BEGIN phase_r0(F, P, layer); } SEAM(pb + 12);
    if (IN(pb + 13)) { PH_BEGIN
        pg8::Gemm g{(const pg8::bf16_t*)(ws + WS_HN), (const pg8::bf16_t*)(ws + WS_WQ), MT, 2048, 1024};
        pg8::StaticOrder S; S.init(MT, 2048, F.G, (int)blockIdx.x);
        EpiSeg E{{(bf16*)(ws + WS_PQ), 2048, 8, (bf16*)(ws + WS_PQ), 2048, 8, (bf16*)(ws + WS_PQ), 2048, 8, (bf16*)(ws + WS_PQ), 2048}};
        pg8::gemm_phase<EpiSeg, pg8::StaticOrder, true, true>(F.lds, g, S, E);
    } SEAM(pb + 13);
    if (IN(pb + 14)) { PH_BEGIN phase_r2(F); } SEAM(pb + 14);
    if (IN(pb + 15)) { PH_BEGIN phase_r3a(F); } SEAM(pb + 15);
    if (IN(pb + 16)) { PH_BEGIN phase_r3f(F); } SEAM(pb + 16);
    if (IN(pb + 17)) { PH_BEGIN phase_r3b(F, P, DRY); } SEAM(pb + 17);
}
__global__ void __launch_bounds__(NTHREADS, 2) hybrid_fwd(Params P) {
    extern __shared__ __attribute__((aligned(16))) unsigned char lds_raw[];
    Frame F;
    F.lds = (LAS unsigned char*)lds_raw; F.ws = (__attribute__((address_space(1))) unsigned char*)P.ws;
    F.tid = threadIdx.x; F.lane = F.tid & 63; F.wave = __builtin_amdgcn_readfirstlane(F.tid >> 6);
    F.G = gridDim.x; { const int bx = blockIdx.x; F.vcu = (F.G % 8 == 0) ? (bx % 8) * (F.G / 8) + bx / 8 : bx; }
    F.gw = F.vcu * NWAVES + F.wave; F.NGW = F.G * NWAVES;
    volatile LAS unsigned* MISC = (volatile LAS unsigned*)(F.lds + MISC_OFF);
    if (F.tid < 16) MISC[F.tid] = 0u;
    __syncthreads();
    unsigned* barw = (unsigned*)(P.ws + WS_CTL) + 1024;
    XcdBarrier bar; bar.bar = barw; bar.x = 0; bar.st = MISC + 8;
    const int lo = P.ph_lo, hi = P.ph_hi;
    if (hi - lo > 1) bar = xcd_barrier_post(barw, MISC + 8);
    layer_body(F, P, bar, 0, lo, hi);
    if (DBG_LAYERS > 1) layer_body(F, P, bar, 1, lo, hi);
}

extern "C" void kernel_launch(void* const* d_in, const int* in_sizes, int n_in, void* d_out, int out_size, void* d_ws, size_t ws_size, hipStream_t stream) {
    static int grid = 0;
    if (grid == 0) {
        if (n_in != 32 || out_size != MT * DM || ws_size < WS_END) { fprintf(stderr, "kernel_launch: unexpected problem shape (n_in %d, out %d, ws %zu)\n", n_in, out_size, ws_size); grid = -1; return; }
        int dev = 0, cus = 0, per_cu = 0;
        if (hipGetDevice(&dev) != hipSuccess || hipDeviceGetAttribute(&cus, hipDeviceAttributeMultiprocessorCount, dev) != hipSuccess) { grid = -1; return; }
        if (hipFuncSetAttribute((const void*)hybrid_fwd, hipFuncAttributeMaxDynamicSharedMemorySize, LDS_BYTES) != hipSuccess) { fprintf(stderr, "kernel_launch: hipFuncSetAttribute failed\n"); grid = -1; return; }
        if (hipOccupancyMaxActiveBlocksPerMultiprocessor(&per_cu, (const void*)hybrid_fwd, NTHREADS, LDS_BYTES) != hipSuccess || per_cu < 1)
            fprintf(stderr, "kernel_launch: note: occupancy query reports %d workgroups per CU\n", per_cu);
        (void)hipGetLastError();
        grid = cus;
    }
    if (grid < 0) return;
    (void)hipMemsetAsync((char*)d_ws + WS_CTL, 0, CTL_ZERO_BYTES, stream);
    Params p{};
#ifndef REP_MASK
#define REP_MASK 0u
#endif
    p.rep_mask = REP_MASK; p.pad = 0;
    for (int i = 0; i < 32; ++i) p.in[i] = (const float*)d_in[i];
    p.out = (float*)d_out; p.ws = (unsigned char*)d_ws;
    const int nph = DBG_LAYERS * NPH;
#if ONE_LAUNCH
    p.ph_lo = 0; p.ph_hi = nph;
    hipLaunchKernelGGL(hybrid_fwd, dim3(grid), dim3(NTHREADS), LDS_BYTES, stream, p);
#else
    for (int k = 0; k < nph; ++k) { p.ph_lo = k; p.ph_hi = k + 1; hipLaunchKernelGGL(hybrid_fwd, dim3(grid), dim3(NTHREADS), LDS_BYTES, stream, p); }
#endif
}
```
